# Optimizing an MI355X kernel written in HIP

```python
import math
import jax, jax.numpy as jnp
from jax import lax
import numpy as np

D_MODEL = 1024
BATCH = 32
SEQ = 2048
DEPTH = 1

MEM_LEN = 256
MEM_HEADS = 4
MEM_HEAD_DIM = 128
GM_WIDTH = D_MODEL // 2
GM_CHUNK = 128
GM_GROUPS = 4
GM_GROUP_W = GM_WIDTH // GM_GROUPS
MLA_HEADS = 8
MLA_NOPE = 128
MLA_ROPE = 64
MLA_V = 128
Q_LORA = 384
KV_LORA = 256
ROPE_BASE = 10000.0
Q_BLOCK = 128
D_FF = 4 * D_MODEL
N_BRANCH = 3
EPS = 1e-6
W_GM = 2 * GM_WIDTH
W_MLA = Q_LORA + KV_LORA + MLA_ROPE
W_MEMQ = MEM_HEADS * MEM_HEAD_DIM
W_GATE = N_BRANCH * D_MODEL
W_IN_COLS = W_GM + W_MLA + W_MEMQ + W_GATE

kernel_name = "hybrid_gmlp_mla_memory_gated_block"


def rmsnorm(x, g):
    xf = x.astype(jnp.float32)
    y = xf * lax.rsqrt(jnp.mean(xf * xf, axis=-1, keepdims=True) + EPS)
    return (y * g.astype(jnp.float32)).astype(x.dtype)


def layernorm(x, g, b):
    xf = x.astype(jnp.float32)
    mu = jnp.mean(xf, axis=-1, keepdims=True)
    xc = xf - mu
    y = xc * lax.rsqrt(jnp.mean(xc * xc, axis=-1, keepdims=True) + EPS)
    return (y * g.astype(jnp.float32) + b.astype(jnp.float32)).astype(x.dtype)


def rope_tables(positions):
    inv_freq = ROPE_BASE ** (-jnp.arange(0, MLA_ROPE, 2, dtype=jnp.float32) / MLA_ROPE)
    ang = positions.astype(jnp.float32)[..., None] * inv_freq
    return jnp.cos(ang), jnp.sin(ang)


def apply_rope(x, cos, sin):
    x1, x2 = jnp.split(x.astype(jnp.float32), 2, axis=-1)
    return jnp.concatenate([x1 * cos - x2 * sin, x2 * cos + x1 * sin], axis=-1).astype(x.dtype)


def gmlp_branch(z_u, z_v, g_ln, b_ln, w_s, b_s):
    B, S, _ = z_u.shape
    u = jax.nn.gelu(z_u)
    v = layernorm(jax.nn.gelu(z_v), g_ln, b_ln)
    v5 = v.reshape(B, S // GM_CHUNK, GM_CHUNK, GM_GROUPS, GM_GROUP_W)
    w_causal = jnp.tril(w_s).astype(v.dtype)
    mixed = jnp.einsum('gts,bnsgw->bntgw', w_causal, v5) + b_s.T[:, :, None].astype(v.dtype)
    return u * mixed.reshape(B, S, GM_WIDTH)


def mla_branch(c_q, c_kv, k_pe, cos, sin, g_cq, w_uq, g_ckv, w_ukv,
               g_q_nope, g_q_pe, g_k_nope, g_k_pe):
    B, S, _ = c_q.shape
    q = (rmsnorm(c_q, g_cq) @ w_uq).reshape(B, S, MLA_HEADS, MLA_NOPE + MLA_ROPE)
    q_nope, q_pe = q[..., :MLA_NOPE], q[..., MLA_NOPE:]
    kv = (rmsnorm(c_kv, g_ckv) @ w_ukv).reshape(B, S, MLA_HEADS, MLA_NOPE + MLA_V)
    k_nope, v = kv[..., :MLA_NOPE], kv[..., MLA_NOPE:]
    q_nope = rmsnorm(q_nope, g_q_nope)
    k_nope = rmsnorm(k_nope, g_k_nope)
    q_pe = apply_rope(rmsnorm(q_pe, g_q_pe), cos[:, :, None, :], sin[:, :, None, :])
    k_pe = apply_rope(rmsnorm(k_pe, g_k_pe), cos, sin)
    scale = 1.0 / math.sqrt(MLA_NOPE + MLA_ROPE)
    nb = S // Q_BLOCK
    qn_b = q_nope.reshape(B, nb, Q_BLOCK, MLA_HEADS, MLA_NOPE).transpose(1, 0, 2, 3, 4)
    qp_b = q_pe.reshape(B, nb, Q_BLOCK, MLA_HEADS, MLA_ROPE).transpose(1, 0, 2, 3, 4)
    key_pos = jnp.arange(S)

    def block(args):
        qn, qp, i = args
        s = (jnp.einsum('bqhd,bkhd->bhqk', qn, k_nope)
             + jnp.einsum('bqhd,bkd->bhqk', qp, k_pe)).astype(jnp.float32) * scale
        q_pos = i * Q_BLOCK + jnp.arange(Q_BLOCK)
        s = jnp.where((q_pos[:, None] >= key_pos[None, :])[None, None], s, -jnp.inf)
        p = jax.nn.softmax(s, axis=-1).astype(v.dtype)
        return jnp.einsum('bhqk,bkhd->bqhd', p, v)

    out = lax.map(block, (qn_b, qp_b, jnp.arange(nb)))
    return out.transpose(1, 0, 2, 3, 4).reshape(B, S, MLA_HEADS * MLA_V)


def memory_branch(q_m, mem, g_mem, w_mem_kv, g_mq, g_mk):
    B, S, _ = q_m.shape
    M = mem.shape[1]
    q = rmsnorm(q_m.reshape(B, S, MEM_HEADS, MEM_HEAD_DIM), g_mq)
    kv = (rmsnorm(mem, g_mem) @ w_mem_kv).reshape(B, M, 2, MEM_HEADS, MEM_HEAD_DIM)
    k = rmsnorm(kv[:, :, 0], g_mk)
    v = kv[:, :, 1]
    s = jnp.einsum('bshd,bmhd->bhsm', q, k).astype(jnp.float32) / math.sqrt(MEM_HEAD_DIM)
    p = jax.nn.softmax(s, axis=-1).astype(v.dtype)
    return jnp.einsum('bhsm,bmhd->bshd', p, v).reshape(B, S, MEM_HEADS * MEM_HEAD_DIM)


def setup_inputs(seed: int = 0) -> dict:
    key = jax.random.key(seed)
    ks = iter(jax.random.split(key, 40))

    def w(shape, fan_in):
        return jax.random.normal(next(ks), (DEPTH,) + shape, jnp.float32) * (fan_in ** -0.5)

    def gain(n):
        return 1.0 + 0.02 * jax.random.normal(next(ks), (DEPTH, n), jnp.float32)

    x = jax.random.normal(next(ks), (BATCH, SEQ, D_MODEL), jnp.float32)
    mem = jax.random.normal(next(ks), (BATCH, MEM_LEN, D_MODEL), jnp.float32)
    offset = jax.random.randint(next(ks), (BATCH, 1), 0, 4096, dtype=jnp.int32)
    positions = (offset + jnp.arange(SEQ, dtype=jnp.int32)[None, :]).astype(jnp.int32)
    return {
        "x": x,
        "mem": mem,
        "positions": positions,
        "g_mix": gain(D_MODEL),
        "w_in": w((D_MODEL, W_IN_COLS), D_MODEL),
        "g_cq": gain(Q_LORA),
        "w_uq": w((Q_LORA, MLA_HEADS * (MLA_NOPE + MLA_ROPE)), Q_LORA),
        "g_ckv": gain(KV_LORA),
        "w_ukv": w((KV_LORA, MLA_HEADS * (MLA_NOPE + MLA_V)), KV_LORA),
        "g_q_nope": gain(MLA_NOPE),
        "g_q_pe": gain(MLA_ROPE),
        "g_k_nope": gain(MLA_NOPE),
        "g_k_pe": gain(MLA_ROPE),
        "g_gm_ln": gain(GM_WIDTH),
        "b_gm_ln": 0.02 * jax.random.normal(next(ks), (DEPTH, GM_WIDTH), jnp.float32),
        "w_spatial": w((GM_GROUPS, GM_CHUNK, GM_CHUNK), GM_CHUNK),
        "b_spatial": 1.0 + 0.02 * jax.random.normal(next(ks), (DEPTH, GM_GROUPS, GM_CHUNK), jnp.float32),
        "g_mem": gain(D_MODEL),
        "w_mem_kv": w((D_MODEL, 2 * MEM_HEADS * MEM_HEAD_DIM), D_MODEL),
        "g_mq": gain(MEM_HEAD_DIM),
        "g_mk": gain(MEM_HEAD_DIM),
        "w_o_gm": w((GM_WIDTH, D_MODEL), GM_WIDTH),
        "w_o_mla": w((MLA_HEADS * MLA_V, D_MODEL), MLA_HEADS * MLA_V),
        "w_o_mem": w((MEM_HEADS * MEM_HEAD_DIM, D_MODEL), MEM_HEADS * MEM_HEAD_DIM),
        "w_out": w((D_MODEL, D_MODEL), D_MODEL),
        "g_ffn": gain(D_MODEL),
        "w_ff1": w((D_MODEL, D_FF), D_MODEL),
        "w_ff2": w((D_FF, D_MODEL), D_FF),
    }


def reference(x, mem, positions, g_mix, w_in, g_cq, w_uq, g_ckv, w_ukv,
              g_q_nope, g_q_pe, g_k_nope, g_k_pe, g_gm_ln, b_gm_ln, w_spatial, b_spatial,
              g_mem, w_mem_kv, g_mq, g_mk, w_o_gm, w_o_mla, w_o_mem, w_out,
              g_ffn, w_ff1, w_ff2):
    cos, sin = rope_tables(positions)
    split_at = [GM_WIDTH, W_GM, W_GM + Q_LORA, W_GM + Q_LORA + KV_LORA,
                W_GM + W_MLA, W_GM + W_MLA + W_MEMQ]
    for l in range(DEPTH):
        h = rmsnorm(x, g_mix[l])
        z = h @ w_in[l]
        z_u, z_v, c_q, c_kv, k_pe, q_m, z_g = jnp.split(z, split_at, axis=-1)
        y_gm = gmlp_branch(z_u, z_v, g_gm_ln[l], b_gm_ln[l], w_spatial[l], b_spatial[l]) @ w_o_gm[l]
        y_mla = mla_branch(c_q, c_kv, k_pe, cos, sin, g_cq[l], w_uq[l], g_ckv[l], w_ukv[l],
                           g_q_nope[l], g_q_pe[l], g_k_nope[l], g_k_pe[l]) @ w_o_mla[l]
        y_mem = memory_branch(q_m, mem, g_mem[l], w_mem_kv[l], g_mq[l], g_mk[l]) @ w_o_mem[l]
        gates = jax.nn.sigmoid(z_g).reshape(z_g.shape[:-1] + (N_BRANCH, D_MODEL))
        merged = gates[..., 0, :] * y_gm + gates[..., 1, :] * y_mla + gates[..., 2, :] * y_mem
        x = x + merged @ w_out[l]
        h2 = rmsnorm(x, g_ffn[l])
        x = x + jnp.square(jax.nn.relu(h2 @ w_ff1[l])) @ w_ff2[l]
    return x
```

```cpp
#include <hip/hip_runtime.h>
#include <hip/hip_cooperative_groups.h>
#include <cstdio>
#include <cstdint>
namespace cg = cooperative_groups;
namespace pg8 {
#define PG8_LAS __attribute__((address_space(3)))
typedef unsigned short bf16_t;
typedef short bf16x8 __attribute__((ext_vector_type(8)));
typedef float f32x4 __attribute__((ext_vector_type(4)));
typedef unsigned u32x4 __attribute__((ext_vector_type(4)));
constexpr int BM = 256, BK = 64, HALF = 128, HTB = HALF * BK * 2  , STAGE_BYTES = 8 * HTB, NXCD = 8, WGM = 8;

__host__ __device__ __forceinline__ int lds_byte(int r, int c) { const int st = (r >> 4) * 2 + (c >> 5), rr = r & 15, cc = c & 31, ob = rr * 64 + cc * 2; return st * 1024 + (ob ^ (((ob >> 9) & 1) << 5)); }
__host__ __device__ __forceinline__ void stage_rc(int b, int& R, int& C) { const int st = b / 1024, sb = b % 1024, swz = sb ^ (((sb >> 9) & 1) << 5); R = (st >> 1) * 16 + swz / 64; C = (st & 1) * 32 + (swz % 64) / 2; }
__host__ __device__ __forceinline__ int perm32(int rho) { const int n = rho >> 4, i = rho & 15; return 8 * (i >> 2) + 4 * n + (i & 3); }

struct Unit { int pm, pn; };
struct Gemm { const bf16_t* A; const bf16_t* Bt; int M, N, K, lda; };

struct StaticOrder {
    int nM, nN, nwg, G, c;
    __host__ __device__ void init(int M, int N, int G_, int c_) { nM = M / BM; nN = N / BM; nwg = nM * nN; G = G_; c = c_; }
    __host__ __device__ bool next(int i, Unit& u) const {
        const long L = (long)i * G + c; if (L >= nwg) return false;
        int wgid = (int)L; { const int q = nwg / NXCD, r = nwg % NXCD, xcd = wgid % NXCD, off = wgid / NXCD; wgid = (xcd < r ? xcd * (q + 1) : r * (q + 1) + (xcd - r) * q) + off; }
        const int nig = WGM * nN, gid = wgid / nig, fm = gid * WGM, gsz = (nM - fm) < WGM ? (nM - fm) : WGM;
        u.pm = fm + ((wgid % nig) % gsz); u.pn = (wgid % nig) / gsz; return true;
    }
    __device__ __forceinline__ void a_ready(const Unit&) const {}
    __device__ __forceinline__ void done(const Unit&) const {}
};

template <class Epi, class Sched, bool ALIGN_EPI = false, bool SP2 = false, int KC = 0, int LDAC = 0>
__device__ __forceinline__ void gemm_phase(PG8_LAS unsigned char* lds, const Gemm g, const Sched& S, const Epi& E) {
    int tid_ = threadIdx.x; asm volatile("" : "+v"(tid_));
    const int tid = tid_, wid = __builtin_amdgcn_readfirstlane(tid >> 6), lane = tid & 63, wr = wid >> 2, wc = wid & 3, fr = lane & 15, fq = lane >> 4;
    const int K = KC ? KC : g.K, nt = K / BK, lda_ = LDAC ? LDAC : g.lda;
    unsigned voffA[2], voffB[2];
#pragma unroll
    for (int i = 0; i < 2; ++i) { int R, C; stage_rc(tid * 16 + i * 8192, R, C); const int Rb = Epi::PERM ? ((R & ~31) + perm32(R & 31)) : R;
        voffA[i] = (unsigned)(R * lda_ + C) * 2u; voffB[i] = (unsigned)(Rb * K + C) * 2u; }
    const size_t kstep = (size_t)(BK * 2);
    const size_t hstepA = (size_t)HALF * lda_ * 2, hstepB = (size_t)HALF * K * 2;
    const size_t tstepA = 2 * hstepA, tstepB = 2 * hstepB;
    const unsigned ldsw = (unsigned)wid * 1024u;
    const int aoff = lds_byte(wr * 64 + fr, fq * 8), boff = lds_byte(wc * 32 + fr, fq * 8);
#define PG8_SA(b, h) (((b) * 2 + (h)) * HTB)
#define PG8_SB(b, h) ((4 + (b) * 2 + (h)) * HTB)
#define PG8_STAGE(bufoff, gbase, voff) do { _Pragma("unroll") for (int _i = 0; _i < 2; ++_i) \
        __builtin_amdgcn_global_load_lds((const unsigned*)((const char*)(gbase) + (voff)[_i]), (PG8_LAS unsigned*)(lds + (bufoff) + ldsw + _i * 8192), 16, 0, 0); } while (0)
#define PG8_LDA(dst, b, h) do { _Pragma("unroll") for (int m = 0; m < 4; ++m) _Pragma("unroll") for (int k = 0; k < 2; ++k) dst[m][k] = *(const PG8_LAS bf16x8*)(lds + PG8_SA(b, h) + aoff + m * 2048 + k * 1024); } while (0)
#define PG8_LDB(dst, b, h) do { _Pragma("unroll") for (int n = 0; n < 2; ++n) _Pragma("unroll") for (int k = 0; k < 2; ++k) dst[n][k] = *(const PG8_LAS bf16x8*)(lds + PG8_SB(b, h) + boff + n * 2048 + k * 1024); } while (0)
#define PG8_MMA(ai, bj, At, Bt) do { __builtin_amdgcn_s_setprio(1); _Pragma("unroll") for (int m = 0; m < 4; ++m) _Pragma("unroll") for (int n = 0; n < 2; ++n) _Pragma("unroll") for (int k = 0; k < 2; ++k) \
        acc[ai][bj][m][n] = __builtin_amdgcn_mfma_f32_16x16x32_bf16(Bt[n][k], At[m][k], acc[ai][bj][m][n], 0, 0, 0); __builtin_amdgcn_s_setprio(0); } while (0)
#define PG8_WAIT_V(n) asm volatile("s_waitcnt vmcnt(" #n ")" ::: "memory")
#define PG8_WAIT_L(n) asm volatile("s_waitcnt lgkmcnt(" #n ")" ::: "memory")
#define PG8_BAR __builtin_amdgcn_s_barrier()
#define PG8_SCHED __builtin_amdgcn_sched_barrier(0)
    Unit cur, nxt; int ui = 0;
    if (!S.next(0, cur)) return;
    f32x4 acc[2][2][4][2];
#pragma unroll
    for (int a = 0; a < 2; ++a)
#pragma unroll
        for (int b = 0; b < 2; ++b)
#pragma unroll
            for (int m = 0; m < 4; ++m)
#pragma unroll
                for (int n = 0; n < 2; ++n) acc[a][b][m][n] = (f32x4){0.f, 0.f, 0.f, 0.f};
    bf16x8 At[4][2], B0[2][2], B1[2][2];
    const char* cA = (const char*)g.A + (size_t)cur.pm * tstepA; const char* cB = (const char*)g.Bt + (size_t)cur.pn * tstepB;
    S.a_ready(cur);
    if constexpr (SP2) {
        PG8_STAGE(PG8_SB(0, 0), cB, voffB); PG8_STAGE(PG8_SB(0, 1), cB + hstepB, voffB); PG8_STAGE(PG8_SA(0, 0), cA, voffA); PG8_STAGE(PG8_SA(0, 1), cA + hstepA, voffA);
        if (wr == 1) PG8_BAR;
        PG8_WAIT_V(2); PG8_BAR;
        PG8_STAGE(PG8_SB(1, 0), cB + kstep, voffB); PG8_STAGE(PG8_SA(1, 0), cA + kstep, voffA); PG8_STAGE(PG8_SB(1, 1), cB + hstepB + kstep, voffB);
        PG8_WAIT_V(6); PG8_BAR;
    } else {
        PG8_STAGE(PG8_SB(0, 0), cB, voffB); PG8_STAGE(PG8_SA(0, 0), cA, voffA); PG8_STAGE(PG8_SB(0, 1), cB + hstepB, voffB); PG8_STAGE(PG8_SA(0, 1), cA + hstepA, voffA);
        if (wr == 1) PG8_BAR;
        PG8_WAIT_V(4); PG8_BAR;
        PG8_STAGE(PG8_SB(1, 0), cB + kstep, voffB); PG8_STAGE(PG8_SA(1, 0), cA + kstep, voffA); PG8_STAGE(PG8_SB(1, 1), cB + hstepB + kstep, voffB);
        PG8_WAIT_V(6); PG8_BAR;
    }
    for (;;) {
        const bool has_next = S.next(ui + 1, nxt);
        const char* nA = has_next ? (const char*)g.A + (size_t)nxt.pm * tstepA : cA; const char* nB = has_next ? (const char*)g.Bt + (size_t)nxt.pn * tstepB : cB;
#pragma unroll 1
        for (int t = 0; t < nt; t += 2) {
            const bool last = (t == nt - 2);
            const char* a1 = cA + (size_t)(t + 1) * kstep;
            const char* a2 = last ? nA : cA + (size_t)(t + 2) * kstep; const char* b2 = last ? nB : cB + (size_t)(t + 2) * kstep;
            const char* a3 = a2 + kstep; const char* b3 = b2 + kstep;
            if (last && has_next) S.a_ready(nxt);
            if constexpr (SP2) {
            PG8_LDB(B0, 0, 0); PG8_LDB(B1, 0, 1); PG8_SCHED; PG8_LDA(At, 0, 0); PG8_STAGE(PG8_SA(1, 1), a1 + hstepA, voffA);
            PG8_WAIT_V(8); PG8_WAIT_L(0); PG8_BAR; PG8_MMA(0, 0, At, B0); PG8_MMA(0, 1, At, B1); PG8_BAR; PG8_SCHED;
            PG8_LDA(At, 0, 1); PG8_STAGE(PG8_SB(0, 0), b2, voffB); PG8_STAGE(PG8_SB(0, 1), b2 + hstepB, voffB); PG8_STAGE(PG8_SA(0, 0), a2, voffA);
            PG8_WAIT_V(8); PG8_WAIT_L(0); PG8_BAR; PG8_MMA(1, 0, At, B0); PG8_MMA(1, 1, At, B1); PG8_BAR; PG8_SCHED;
            PG8_LDB(B0, 1, 0); PG8_LDB(B1, 1, 1); PG8_SCHED; PG8_LDA(At, 1, 0); PG8_STAGE(PG8_SA(0, 1), a2 + hstepA, voffA);
            PG8_WAIT_V(8); PG8_WAIT_L(0); PG8_BAR; PG8_MMA(0, 0, At, B0); PG8_MMA(0, 1, At, B1); PG8_BAR; PG8_SCHED;
            PG8_LDA(At, 1, 1); PG8_STAGE(PG8_SB(1, 0), b3, voffB); PG8_STAGE(PG8_SB(1, 1), b3 + hstepB, voffB); PG8_STAGE(PG8_SA(1, 0), a3, voffA);
            PG8_WAIT_V(8); PG8_WAIT_L(0); PG8_BAR; PG8_MMA(1, 0, At, B0); PG8_MMA(1, 1, At, B1); PG8_BAR; PG8_SCHED;
            } else {
            PG8_LDB(B0, 0, 0); PG8_SCHED; PG8_LDA(At, 0, 0); PG8_STAGE(PG8_SA(1, 1), a1 + hstepA, voffA);
            PG8_WAIT_L(8); PG8_BAR; PG8_WAIT_L(0); PG8_MMA(0, 0, At, B0); PG8_BAR; PG8_SCHED;
            PG8_LDB(B1, 0, 1); PG8_STAGE(PG8_SB(0, 0), b2, voffB);
            PG8_BAR; PG8_WAIT_L(0); PG8_MMA(0, 1, At, B1); PG8_BAR;
            PG8_LDA(At, 0, 1); PG8_STAGE(PG8_SA(0, 0), a2, voffA);
            PG8_BAR; PG8_WAIT_L(0); PG8_MMA(1, 0, At, B0); PG8_BAR; PG8_SCHED;
            PG8_STAGE(PG8_SB(0, 1), b2 + hstepB, voffB);
            PG8_WAIT_V(6); PG8_BAR; PG8_MMA(1, 1, At, B1); PG8_BAR;
            PG8_LDB(B0, 1, 0); PG8_SCHED; PG8_LDA(At, 1, 0); PG8_STAGE(PG8_SA(0, 1), a2 + hstepA, voffA);
            PG8_WAIT_L(8); PG8_BAR; PG8_WAIT_L(0); PG8_MMA(0, 0, At, B0); PG8_BAR; PG8_SCHED;
            PG8_LDB(B1, 1, 1); PG8_STAGE(PG8_SB(1, 0), b3, voffB);
            PG8_BAR; PG8_WAIT_L(0); PG8_MMA(0, 1, At, B1); PG8_BAR;
            PG8_LDA(At, 1, 1); PG8_STAGE(PG8_SA(1, 0), a3, voffA);
            PG8_BAR; PG8_WAIT_L(0); PG8_MMA(1, 0, At, B0); PG8_BAR; PG8_SCHED;
            PG8_STAGE(PG8_SB(1, 1), b3 + hstepB, voffB);
            PG8_WAIT_V(6); PG8_BAR; PG8_MMA(1, 1, At, B1); PG8_BAR;
            }
        }
        if constexpr (ALIGN_EPI) { if (wr == 0) PG8_BAR; }
        if constexpr (!Epi::AFTER_DRAIN) { E(acc, cur, wr, wc, fr, fq); S.done(cur); }
        if (!has_next) break;
#pragma unroll
        for (int a = 0; a < 2; ++a)
#pragma unroll
            for (int b = 0; b < 2; ++b)
#pragma unroll
                for (int m = 0; m < 4; ++m)
#pragma unroll
                    for (int n = 0; n < 2; ++n) acc[a][b][m][n] = (f32x4){0.f, 0.f, 0.f, 0.f};
        cur = nxt; cA = nA; cB = nB; ++ui;
        if constexpr (ALIGN_EPI) { if (wr == 1) PG8_BAR; }
    }
    PG8_WAIT_V(0);
    if constexpr (!ALIGN_EPI) { if (wr == 0) PG8_BAR; }
    PG8_BAR;
    if constexpr (Epi::AFTER_DRAIN) { E.fused(acc, cur, wr, wc, fr, fq, lds, wid, lane); S.done(cur); }
#undef PG8_SA
#undef PG8_SB
#undef PG8_STAGE
#undef PG8_LDA
#undef PG8_LDB
#undef PG8_MMA
#undef PG8_WAIT_V
#undef PG8_WAIT_L
#undef PG8_BAR
#undef PG8_SCHED
}
}

#define LAS __attribute__((address_space(3)))
#define DI __device__ __forceinline__
using pg8::bf16_t; using pg8::bf16x8; using pg8::f32x4; using pg8::u32x4;
typedef short s16x4 __attribute__((ext_vector_type(4)));
typedef short v4i16_t __attribute__((ext_vector_type(4)));
typedef float f32x16 __attribute__((ext_vector_type(16)));
typedef float f32x2_t __attribute__((ext_vector_type(2)));
typedef __bf16 bf16x2_t __attribute__((ext_vector_type(2)));
typedef unsigned u32x2 __attribute__((ext_vector_type(2)));

constexpr int T = 65536, SEQ = 2048, NB = 32, DM = 1024, MEMT = 8192, MEML = 256;
constexpr float EPSN = 1e-6f, LOG2E = 1.4426950408889634f;
constexpr size_t MiB = 1u << 20;
constexpr size_t W_IN = 0, W_UQ = 11 * MiB, W_UKV = 13 * MiB, W_MKV = 14 * MiB, W_OGM = 16 * MiB, W_OMLA = 17 * MiB, W_OMEM = 19 * MiB, W_WOUT = 20 * MiB, W_FF1 = 22 * MiB, W_FF2 = 30 * MiB;
constexpr size_t S_WSP = 39 * MiB + 512 * 1024;
constexpr size_t S_BAR = 39 * MiB;
constexpr size_t S_RSX = 40 * MiB, S_RSM = S_RSX + 256 * 1024, S_SSQCQ = 41 * MiB, S_SSQCKV = 44 * MiB, S_SSQ2 = 46 * MiB, S_ROPE = 50 * MiB;
constexpr size_t A_ZU = 72 * MiB, A_ZV = 136 * MiB, A_X1B = 72 * MiB, A_MEMB = 200 * MiB, A_MEMKV = 216 * MiB, A_Q = 232 * MiB, A_XB = 232 * MiB;
constexpr size_t A_ZCQ = 424 * MiB, A_ZCKV = 488 * MiB, A_ZQM = 520 * MiB, A_ZG = 584 * MiB, A_HDN = 200 * MiB, A_X1 = 712 * MiB, WS_NEED = 968 * MiB;
constexpr int RING_BYTES = 131072, P_OFF = RING_BYTES, LDS_BYTES = 147456;

DI unsigned cvtpk(float lo, float hi) { f32x2_t v = {lo, hi}; bf16x2_t b = __builtin_convertvector(v, bf16x2_t); return __builtin_bit_cast(unsigned, b); }
DI float bflo(unsigned w) { return __uint_as_float(w << 16); }
DI float bfhi(unsigned w) { return __uint_as_float(w & 0xffff0000u); }
DI float wave_sum(float v) {
    v += __builtin_bit_cast(float, __builtin_amdgcn_update_dpp(0, __builtin_bit_cast(int, v), 0x121, 0xf, 0xf, false));
    v += __builtin_bit_cast(float, __builtin_amdgcn_update_dpp(0, __builtin_bit_cast(int, v), 0x122, 0xf, 0xf, false));
    v += __builtin_bit_cast(float, __builtin_amdgcn_update_dpp(0, __builtin_bit_cast(int, v), 0x124, 0xf, 0xf, false));
    v += __builtin_bit_cast(float, __builtin_amdgcn_update_dpp(0, __builtin_bit_cast(int, v), 0x128, 0xf, 0xf, false));
    { const auto r = __builtin_amdgcn_permlane16_swap(__float_as_uint(v), __float_as_uint(v), false, false); v = __uint_as_float(r[0]) + __uint_as_float(r[1]); }
    { const auto r = __builtin_amdgcn_permlane32_swap(__float_as_uint(v), __float_as_uint(v), false, false); v = __uint_as_float(r[0]) + __uint_as_float(r[1]); }
    return v;
}
DI float xsum16(float s) { const auto r = __builtin_amdgcn_permlane16_swap(__float_as_uint(s), __float_as_uint(s), false, false); return __uint_as_float(r[0]) + __uint_as_float(r[1]); }
DI float xsum32(float s) { const auto r = __builtin_amdgcn_permlane32_swap(__float_as_uint(s), __float_as_uint(s), false, false); return __uint_as_float(r[0]) + __uint_as_float(r[1]); }
DI float xmax32(float s) { const auto r = __builtin_amdgcn_permlane32_swap(__float_as_uint(s), __float_as_uint(s), false, false); return fmaxf(__uint_as_float(r[0]), __uint_as_float(r[1])); }
DI float gelu_t(float x) { const float t = x + 0.044715f * x * x * x; return x * __builtin_amdgcn_rcpf(1.0f + __builtin_amdgcn_exp2f(-2.3022082f * t)); }
DI float sigm(float x) { return __builtin_amdgcn_rcpf(1.0f + __builtin_amdgcn_exp2f(-LOG2E * x)); }
DI void st8(bf16_t* p, const float (&v)[8]) { u32x4 w; w.x = cvtpk(v[0], v[1]); w.y = cvtpk(v[2], v[3]); w.z = cvtpk(v[4], v[5]); w.w = cvtpk(v[6], v[7]); *(u32x4*)p = w; }
DI void ld8f(const float* p, float (&v)[8]) { const f32x4 a = *(const f32x4*)p, b = *(const f32x4*)(p + 4); v[0] = a[0]; v[1] = a[1]; v[2] = a[2]; v[3] = a[3]; v[4] = b[0]; v[5] = b[1]; v[6] = b[2]; v[7] = b[3]; }
DI void ld8b(const bf16_t* p, float (&v)[8]) { const u32x4 w = *(const u32x4*)p; v[0] = bflo(w.x); v[1] = bfhi(w.x); v[2] = bflo(w.y); v[3] = bfhi(w.y); v[4] = bflo(w.z); v[5] = bfhi(w.z); v[6] = bflo(w.w); v[7] = bfhi(w.w); }
#define EPI_BAR() do { asm volatile("s_waitcnt lgkmcnt(0)" ::: "memory"); __builtin_amdgcn_s_barrier(); asm volatile("" ::: "memory"); } while (0)

struct Bag {
    const float *x, *g_qn, *g_qp, *g_kn, *g_kp, *g_mq, *g_mk;
    float *rstd_x, *rstd_mem, *ssq_cq, *ssq_ckv, *ssq2; const float* rope;
    bf16_t *zU, *zV, *zCQ, *zCKV, *zQM, *zG, *q, *kv, *memkv, *merged, *x1b, *hdn;
    float *x1, *out;
    LAS float* P;
};
typedef f32x4 AccT[2][2][4][2];
#define ACC8(v, ai, bj, m, s) do { const f32x4 a_ = acc[ai][bj][m][0] * (s), b_ = acc[ai][bj][m][1] * (s); v[0] = a_[0]; v[1] = a_[1]; v[2] = a_[2]; v[3] = a_[3]; v[4] = b_[0]; v[5] = b_[1]; v[6] = b_[2]; v[7] = b_[3]; } while (0)
DI float ssq8(const float (&v)[8]) { float s = (v[0] * v[0] + v[1] * v[1]) + (v[2] * v[2] + v[3] * v[3]) + (v[4] * v[4] + v[5] * v[5]) + (v[6] * v[6] + v[7] * v[7]); s = xsum16(s); s = xsum32(s); return s; }

template <int NS> DI void row_scales(const float* rsp, float inv, int grow0, float (&rs)[8]) {
#pragma unroll
    for (int it = 0; it < 8; ++it) rs[it] = rsp[grow0 + (it >> 2) * 128 + (it & 3) * 16];
    if (NS != 0) {
#pragma unroll
        for (int it = 0; it < 8; ++it) rs[it] = __builtin_amdgcn_rsqf(rs[it] * inv + EPSN); }
}
template <int GS, bool ROPE, int NS>
DI void headnorm(const AccT& acc, const float* rsp, float rs_inv, const float* gain, float oscale, bf16_t* dst, int ld, int grow0, int bj_lo,
                 int wr, int wc, int fr, int fq, LAS float* P, const float* rope) {
    const int rowl0 = wr * 64 + fr, cl0 = wc * 32 + 8 * fq, ch = cl0 & (GS - 1);
#pragma unroll
    for (int ai = 0; ai < 2; ++ai)
#pragma unroll
        for (int m = 0; m < 4; ++m)
#pragma unroll
            for (int bj = 0; bj < 2; ++bj) { if (bj < bj_lo) continue; float v[8]; ACC8(v, ai, bj, m, 1.0f); const float s = ssq8(v);
                if (fq == 0) P[(ai * 128 + m * 16 + rowl0) * 8 + bj * 4 + wc] = s; }
    EPI_BAR();
    float rs[8]; row_scales<NS>(rsp, rs_inv, grow0, rs);
    float g8[8];
    if (ROPE) { const int p0 = ch >> 1;
#pragma unroll
        for (int e = 0; e < 8; ++e) g8[e] = gain[(e & 1) * 32 + p0 + (e >> 1)] * oscale;
    } else { ld8f(gain + ch, g8);
#pragma unroll
        for (int e = 0; e < 8; ++e) g8[e] *= oscale; }
    f32x4 cs[4][2];
#define CS_LOAD(itn) do { const size_t gn_ = (size_t)(grow0 + ((itn) >> 2) * 128 + ((itn) & 3) * 16); cs[(itn) & 3][0] = *(const f32x4*)(rope + gn_ * 64 + ch); cs[(itn) & 3][1] = *(const f32x4*)(rope + gn_ * 64 + ch + 4); } while (0)
    if (ROPE) { CS_LOAD(0); CS_LOAD(1); CS_LOAD(2); CS_LOAD(3); }
#pragma unroll
    for (int it = 0; it < 8; ++it) { const int ai = it >> 2, m = it & 3, rl = ai * 128 + m * 16 + rowl0; const size_t grow = (size_t)(grow0 + ai * 128 + m * 16);
        __builtin_amdgcn_sched_barrier(0);
#pragma unroll
        for (int bj = 0; bj < 2; ++bj) { if (bj < bj_lo) continue;
            const f32x4 p4 = *(const LAS f32x4*)(P + rl * 8 + bj * 4);
            const float tot = ((GS == 128) ? (p4[0] + p4[1]) + (p4[2] + p4[3]) : (wc < 2 ? p4[0] + p4[1] : p4[2] + p4[3])) * rs[it] * rs[it];
            const float r = __builtin_amdgcn_rsqf(tot * (1.0f / GS) + EPSN) * rs[it];
            float v[8]; ACC8(v, ai, bj, m, r);
#pragma unroll
            for (int e = 0; e < 8; ++e) v[e] *= g8[e];
            if (ROPE) { const f32x4 c0 = cs[it & 3][0], c1 = cs[it & 3][1]; const float cv[8] = {c0[0], c0[1], c0[2], c0[3], c1[0], c1[1], c1[2], c1[3]};
#pragma unroll
                for (int k = 0; k < 4; ++k) { const float a = v[2 * k], b = v[2 * k + 1], c = cv[2 * k], sn = cv[2 * k + 1]; v[2 * k] = a * c - b * sn; v[2 * k + 1] = b * c + a * sn; } }
            st8(dst + grow * ld + bj * 128 + cl0, v); }
        __builtin_amdgcn_sched_barrier(0); if (ROPE && it + 4 < 8) CS_LOAD(it + 4); __builtin_amdgcn_sched_barrier(0); }
#undef CS_LOAD
}

enum { K_Z = 0, K_MEMKV, K_Q, K_KV, K_OUT, K_WOUT, K_FF1, K_FF2 };
template <int KIND> struct Epi {
    static constexpr bool PERM = true, AFTER_DRAIN = false;
    Bag b; int br;
    DI void operator()(const AccT& acc, const pg8::Unit& u, int wr, int wc, int fr_in, int fq_in) const {
        int ln_; asm volatile("v_mbcnt_lo_u32_b32 %0, -1, 0\n\tv_mbcnt_hi_u32_b32 %0, -1, %0" : "=v"(ln_));
        const int fr = ln_ & 15, fq = ln_ >> 4; (void)fr_in; (void)fq_in;
        const int grow0 = u.pm * 256 + wr * 64 + fr, cl0 = wc * 32 + 8 * fq, pn = u.pn, tc0 = pn * 256 + cl0;
#define IT_AI (it >> 2)
#define IT_M (it & 3)
#define IT_ROW ((size_t)(grow0 + (it >> 2) * 128 + (it & 3) * 16))
#define ITLOOP _Pragma("unroll") for (int it = 0; it < 8; ++it)
#define BJLOOP _Pragma("unroll") for (int bj = 0; bj < 2; ++bj)
#define SBE() __builtin_amdgcn_sched_barrier(0)
        if (KIND == K_Z) {
            float rs[8]; row_scales<0>(b.rstd_x, 0.f, grow0, rs);
            if (pn < 4) { bf16_t* dst = (pn < 2 ? b.zU : b.zV) + (pn & 1) * 256 + cl0;
                ITLOOP { BJLOOP { float v[8]; ACC8(v, IT_AI, bj, IT_M, rs[it]);
#pragma unroll
                    for (int e = 0; e < 8; ++e) v[e] = gelu_t(v[e]);
                    st8(dst + IT_ROW * 512 + bj * 128, v); } SBE(); }
            } else if (pn == 4 || pn == 6) { bf16_t* dst = (pn == 4 ? b.zCQ : b.zCKV) + cl0; const int ld = (pn == 4) ? 512 : 256; float* sq = (pn == 4) ? b.ssq_cq : b.ssq_ckv;
                ITLOOP { float s = 0.f; BJLOOP { float v[8]; ACC8(v, IT_AI, bj, IT_M, rs[it]); s += ssq8(v); st8(dst + IT_ROW * ld + bj * 128, v); } if (fq == 0) __hip_atomic_fetch_add(sq + IT_ROW, s, __ATOMIC_RELAXED, __HIP_MEMORY_SCOPE_AGENT); SBE(); }
            } else if (pn == 5) {
                ITLOOP { float v[8]; ACC8(v, IT_AI, 0, IT_M, rs[it]); const float s = ssq8(v); st8(b.zCQ + IT_ROW * 512 + 256 + cl0, v); if (fq == 0) __hip_atomic_fetch_add(b.ssq_cq + IT_ROW, s, __ATOMIC_RELAXED, __HIP_MEMORY_SCOPE_AGENT); SBE(); }
                headnorm<64, true, 0>(acc, b.rstd_x, 0.f, b.g_kp, 1.0f, b.zCQ + 256, 512, grow0, 1, wr, wc, fr, fq, b.P, b.rope);
            } else if (pn < 9) {
                headnorm<128, false, 0>(acc, b.rstd_x, 0.f, b.g_mq, LOG2E * 0.08838834764831845f, b.zQM + (pn - 7) * 256, 512, grow0, 0, wr, wc, fr, fq, b.P, nullptr);
            } else { bf16_t* dst = b.zG + (pn - 9) * 256 + cl0;
                ITLOOP { BJLOOP { float v[8]; ACC8(v, IT_AI, bj, IT_M, rs[it]);
#pragma unroll
                    for (int e = 0; e < 8; ++e) v[e] = sigm(v[e]);
                    st8(dst + IT_ROW * 3072 + bj * 128, v); } SBE(); }
            }
        }
        if (KIND == K_MEMKV) {
            if (pn < 2) headnorm<128, false, 0>(acc, b.rstd_mem, 0.f, b.g_mk, 1.0f, b.memkv + pn * 256, 1024, grow0, 0, wr, wc, fr, fq, b.P, nullptr);
            else { float rs[8]; row_scales<0>(b.rstd_mem, 0.f, grow0, rs); ITLOOP { BJLOOP { float v[8]; ACC8(v, IT_AI, bj, IT_M, rs[it]); st8(b.memkv + IT_ROW * 1024 + tc0 + bj * 128, v); } SBE(); } }
        }
        if (KIND == K_Q) {
            const float qs = LOG2E * 0.07216878364870323f;
            if (pn < 4) headnorm<128, false, 1>(acc, b.ssq_cq, 1.0f / 384.0f, b.g_qn, qs, b.q + pn * 256, 1536, grow0, 0, wr, wc, fr, fq, b.P, nullptr);
            else headnorm<64, true, 1>(acc, b.ssq_cq, 1.0f / 384.0f, b.g_qp, qs, b.q + pn * 256, 1536, grow0, 0, wr, wc, fr, fq, b.P, b.rope);
        }
        if (KIND == K_KV) {
            if (pn < 4) headnorm<128, false, 1>(acc, b.ssq_ckv, 1.0f / 256.0f, b.g_kn, 1.0f, b.kv + pn * 256, 2048, grow0, 0, wr, wc, fr, fq, b.P, nullptr);
            else { float rs[8]; row_scales<1>(b.ssq_ckv, 1.0f / 256.0f, grow0, rs); ITLOOP { BJLOOP { float v[8]; ACC8(v, IT_AI, bj, IT_M, rs[it]); st8(b.kv + IT_ROW * 2048 + tc0 + bj * 128, v); } SBE(); } }
        }
        if (KIND == K_OUT) {
            const int brn = br & 3; const bool accum = (br >> 8) != 0;
            u32x4 pg[4][2], pm[4][2];
#define OUT_LOAD(itn, buf) do { const size_t rw_ = (size_t)(grow0 + ((itn) >> 2) * 128 + ((itn) & 3) * 16); BJLOOP { pg[buf][bj] = *(const u32x4*)(b.zG + rw_ * 3072 + brn * 1024 + tc0 + bj * 128); \
                if (accum) pm[buf][bj] = *(const u32x4*)(b.merged + rw_ * 1024 + tc0 + bj * 128); } } while (0)
            OUT_LOAD(0, 0); OUT_LOAD(1, 1); OUT_LOAD(2, 2); OUT_LOAD(3, 3); SBE();
            ITLOOP {
                BJLOOP { const u32x4 gw = pg[it & 3][bj]; const float g[8] = {bflo(gw.x), bfhi(gw.x), bflo(gw.y), bfhi(gw.y), bflo(gw.z), bfhi(gw.z), bflo(gw.w), bfhi(gw.w)};
                    float v[8]; ACC8(v, IT_AI, bj, IT_M, 1.0f);
                    if (accum) { const u32x4 ow = pm[it & 3][bj]; const float o[8] = {bflo(ow.x), bfhi(ow.x), bflo(ow.y), bfhi(ow.y), bflo(ow.z), bfhi(ow.z), bflo(ow.w), bfhi(ow.w)};
#pragma unroll
                        for (int e = 0; e < 8; ++e) v[e] = o[e] + g[e] * v[e];
                    } else {
#pragma unroll
                        for (int e = 0; e < 8; ++e) v[e] = g[e] * v[e]; }
                    st8(b.merged + IT_ROW * 1024 + tc0 + bj * 128, v); }
                SBE(); if (it + 4 < 8) OUT_LOAD(it + 4, it & 3); SBE(); }
#undef OUT_LOAD
        }
        if (KIND == K_WOUT) {
            f32x4 px[4][2][2];
#define RES_LOAD(itn, buf) do { const float* p_ = b.x + (size_t)(grow0 + ((itn) >> 2) * 128 + ((itn) & 3) * 16) * 1024 + tc0; BJLOOP { px[buf][bj][0] = *(const f32x4*)(p_ + bj * 128); px[buf][bj][1] = *(const f32x4*)(p_ + bj * 128 + 4); } } while (0)
            RES_LOAD(0, 0); RES_LOAD(1, 1); RES_LOAD(2, 2); RES_LOAD(3, 3); SBE();
            ITLOOP {
                float s = 0.f;
                BJLOOP { float v[8]; ACC8(v, IT_AI, bj, IT_M, 1.0f); const f32x4 x0 = px[it & 3][bj][0], x1v = px[it & 3][bj][1];
                    v[0] += x0[0]; v[1] += x0[1]; v[2] += x0[2]; v[3] += x0[3]; v[4] += x1v[0]; v[5] += x1v[1]; v[6] += x1v[2]; v[7] += x1v[3];
#pragma unroll
                    for (int e = 0; e < 8; ++e) s += v[e] * v[e];
                    st8(b.x1b + IT_ROW * 1024 + tc0 + bj * 128, v); }
                s = xsum16(s); s = xsum32(s); if (fq == 0) __hip_atomic_fetch_add(b.ssq2 + IT_ROW, s, __ATOMIC_RELAXED, __HIP_MEMORY_SCOPE_AGENT);
                SBE(); if (it + 4 < 8) RES_LOAD(it + 4, it & 3); SBE(); }
#undef RES_LOAD
        }
        if (KIND == K_FF2) {
            u32x4 px[4][2];
#define RES_LOAD(itn, buf) do { const bf16_t* p_ = b.x1b + (size_t)(grow0 + ((itn) >> 2) * 128 + ((itn) & 3) * 16) * 1024 + tc0; BJLOOP { px[buf][bj] = *(const u32x4*)(p_ + bj * 128); } } while (0)
            RES_LOAD(0, 0); RES_LOAD(1, 1); RES_LOAD(2, 2); RES_LOAD(3, 3); SBE();
            ITLOOP {
                BJLOOP { float v[8]; ACC8(v, IT_AI, bj, IT_M, 1.0f); const u32x4 w = px[it & 3][bj];
                    float* op = b.out + IT_ROW * 1024 + tc0 + bj * 128;
                    *(f32x4*)op = (f32x4){v[0] + bflo(w.x), v[1] + bfhi(w.x), v[2] + bflo(w.y), v[3] + bfhi(w.y)}; *(f32x4*)(op + 4) = (f32x4){v[4] + bflo(w.z), v[5] + bfhi(w.z), v[6] + bflo(w.w), v[7] + bfhi(w.w)}; }
                SBE(); if (it + 4 < 8) RES_LOAD(it + 4, it & 3); SBE(); }
#undef RES_LOAD
        }
        if (KIND == K_FF1) {
            float rs[8]; row_scales<1>(b.ssq2, 1.0f / 1024.0f, grow0, rs);
            ITLOOP { BJLOOP { float v[8]; ACC8(v, IT_AI, bj, IT_M, rs[it]);
#pragma unroll
                for (int e = 0; e < 8; ++e) { const float t = fmaxf(v[e], 0.f); v[e] = t * t; }
                st8(b.hdn + IT_ROW * 4096 + tc0 + bj * 128, v); } SBE(); }
        }
#undef IT_AI
#undef IT_M
#undef IT_ROW
#undef ITLOOP
#undef BJLOOP
#undef SBE
    }
};

DI int crow(int r, int hi) { return (r & 3) + 8 * (r >> 2) + 4 * hi; }
DI s16x4 vtr(const LAS char* p) { return __builtin_bit_cast(s16x4, __builtin_amdgcn_ds_read_tr16_b64_v4i16((LAS v4i16_t*)p)); }
#define MFMA32(a, b, c) __builtin_amdgcn_mfma_f32_32x32x16_bf16((a), (b), (c), 0, 0, 0)
DI bf16x8 pack8(const f32x16& x, int o) { u32x4 w; w.x = cvtpk(x[o], x[o + 1]); w.y = cvtpk(x[o + 2], x[o + 3]); w.z = cvtpk(x[o + 4], x[o + 5]); w.w = cvtpk(x[o + 6], x[o + 7]); return __builtin_bit_cast(bf16x8, w); }

template <int DQK, bool CAUSAL, int ABL = 0>
DI void attn_unit(LAS char* lds, const bf16_t* Qa, int pQa, const bf16_t* Qb, int pQb, const bf16_t* Ka, int pKa, const bf16_t* Kb, int pKb,
                  const bf16_t* V, int pV, bf16_t* O, int pO, int q0, int NT) {
    constexpr int KP = DQK * 2 + 16, VP = 320, KBUF = 64 * KP, VBUF = 64 * VP, SLOT = KBUF + VBUF, NDS = DQK / 16, KB = (DQK == 192) ? 3 : 4, NKB = NDS / KB;
    constexpr int KC16 = KP / 16, NKC = KBUF / 1024, NVC = VBUF / 1024, NCH = NKC + NVC, NOPS = (NCH + 7) / 8;
    static_assert(KBUF % 1024 == 0 && VBUF % 1024 == 0 && 3 * SLOT <= P_OFF + 8192 && (NOPS == 5 || NOPS == 6), "attention ring geometry");
    int tid_ = threadIdx.x; asm volatile("" : "+v"(tid_));
    const int tid = tid_, lane = tid & 63, wid = __builtin_amdgcn_readfirstlane(tid >> 6), r = lane & 31, h = lane >> 5;
    const size_t qrow = (size_t)(q0 + 32 * wid + r);
    __syncthreads();
    bf16x8 qf[NDS];
#pragma unroll
    for (int ds = 0; ds < 8; ++ds) qf[ds] = *(const bf16x8*)(Qa + qrow * pQa + 16 * ds + 8 * h);
    if (DQK == 192) {
#pragma unroll
        for (int ds = 8; ds < NDS; ++ds) qf[ds] = *(const bf16x8*)(Qb + qrow * pQb + 16 * (ds - 8) + 8 * h); }
    const char* gp[NOPS]; unsigned ginc[NOPS]; int loff[NOPS];
#pragma unroll
    for (int j = 0; j < NOPS; ++j) { const int c = (wid + 8 * j < NCH) ? wid + 8 * j : NCH - 1; loff[j] = c * 1024;
        if (c < NKC) { const int idx = 64 * c + lane, row = idx / KC16, cb = idx - row * KC16;
            if (DQK == 192 && cb >= 16 && cb < 24) { gp[j] = (const char*)(Kb + (size_t)row * pKb + (cb - 16) * 8); ginc[j] = 64u * (unsigned)pKb * 2u; }
            else { gp[j] = (const char*)(Ka + (size_t)row * pKa + (cb < 16 ? cb * 8 : 0)); ginc[j] = 64u * (unsigned)pKa * 2u; }
        } else { const int idx = 64 * (c - NKC) + lane, row = idx / 20, cb = idx - row * 20;
            gp[j] = (const char*)(V + (size_t)row * pV + (cb < 16 ? cb * 8 : 0)); ginc[j] = 64u * (unsigned)pV * 2u; } }
#define AT_ISSUE(slot) do { if (ABL & 8) break; _Pragma("unroll") for (int j = 0; j < NOPS; ++j) { \
        __builtin_amdgcn_global_load_lds((const unsigned*)gp[j], (LAS unsigned*)(lds + (slot) * SLOT + loff[j]), 16, 0, 0); gp[j] += ginc[j]; } } while (0)
#define AT_WAITBAR(n) asm volatile("s_waitcnt vmcnt(" #n ") lgkmcnt(0)\n\ts_barrier" ::: "memory")
#define AT_WAIT_NEWEST() do { if (NOPS == 6) AT_WAITBAR(6); else AT_WAITBAR(5); } while (0)
#define SB() __builtin_amdgcn_sched_barrier(0)
#define LDK(dst, bi) do { _Pragma("unroll") for (int j = 0; j < KB; ++j) { dst[2 * j] = *(const LAS bf16x8*)(kb_ + ((bi) * KB + j) * 32); dst[2 * j + 1] = *(const LAS bf16x8*)(kb_ + 32 * KP + ((bi) * KB + j) * 32); } } while (0)
#define MMK(src, bi) do { if (ABL & 1) { _Pragma("unroll") for (int j = 0; j < KB; ++j) { s0[j] += (float)src[2 * j][0]; s1[j] += (float)src[2 * j + 1][0]; } break; } _Pragma("unroll") for (int j = 0; j < KB; ++j) { s0 = MFMA32(src[2 * j], qf[(bi) * KB + j], s0); s1 = MFMA32(src[2 * j + 1], qf[(bi) * KB + j], s1); } } while (0)
#define TRR(dst, off) asm volatile("ds_read_b64_tr_b16 %0, %1 offset:%c2" : "=&v"(dst) : "v"(va_), "i"(off) : "memory")
#define LDV(lo, hi, s) do { _Pragma("unroll") for (int d = 0; d < 4; ++d) { TRR(lo[d], (16 * (s)) * VP + d * 64); TRR(hi[d], (16 * (s) + 8) * VP + d * 64); } } while (0)
#define MMV(lo, hi, s) do { if (ABL & 4) { _Pragma("unroll") for (int d = 0; d < 4; ++d) o[d][0] += (float)lo[d][0] + (float)hi[d][0] + (float)pf[s][d]; break; } _Pragma("unroll") for (int d = 0; d < 4; ++d) o[d] = MFMA32(((bf16x8){lo[d][0], lo[d][1], lo[d][2], lo[d][3], hi[d][0], hi[d][1], hi[d][2], hi[d][3]}), pf[s], o[d]); } while (0)
#define LGKM(n) asm volatile("s_waitcnt lgkmcnt(" #n ")" ::: "memory")
    asm volatile("s_waitcnt vmcnt(0)" ::: "memory");
    AT_ISSUE(0);
    if (NT > 1) { AT_ISSUE(1); AT_WAIT_NEWEST(); } else { AT_WAITBAR(0); }
    float mrow = -INFINITY, lsum = 0.f;
    f32x16 o[4];
#pragma unroll
    for (int d = 0; d < 4; ++d)
#pragma unroll
        for (int i = 0; i < 16; ++i) o[d][i] = 0.f;
    const int qmin = q0 + 32 * wid, qpos = qmin + r;
    const int q4 = (lane & 15) >> 2, p4 = lane & 3, blk = (lane >> 4) & 1;
    int sc = 0, sn2 = 2;
#pragma unroll 1
    for (int t = 0; t < NT; ++t) {
        if (t + 2 < NT) AT_ISSUE(sn2);
        const bool active = !CAUSAL || (64 * t <= qmin + 31);
        if (active) {
            const LAS char* kb_ = lds + sc * SLOT + r * KP + 16 * h; const LAS char* vb_ = lds + sc * SLOT + KBUF + (4 * h + q4) * VP + blk * 32 + p4 * 8;
            f32x16 s0, s1;
#pragma unroll
            for (int i = 0; i < 16; ++i) { s0[i] = 0.f; s1[i] = 0.f; }
            bf16x8 fa[2 * KB], fb[2 * KB];
            SB(); LDK(fa, 0); SB();
#pragma unroll
            for (int bi = 0; bi < NKB; ++bi) {
                if (bi & 1) { if (bi + 1 < NKB) LDK(fa, bi + 1); SB(); MMK(fb, bi); SB(); }
                else { if (bi + 1 < NKB) LDK(fb, bi + 1); SB(); MMK(fa, bi); SB(); } }
            if (CAUSAL && (64 * t + 63 > qmin)) {
#pragma unroll
                for (int i = 0; i < 16; ++i) { const int kv = 64 * t + crow(i, h); if (kv > qpos) s0[i] = -INFINITY; if (kv + 32 > qpos) s1[i] = -INFINITY; } }
            float a_ = fmaxf(fmaxf(s0[0], s0[1]), s1[0]), b_ = fmaxf(fmaxf(s0[2], s0[3]), s1[1]); a_ = fmaxf(fmaxf(a_, s1[2]), s1[3]);
#pragma unroll
            for (int i = 4; i < 16; i += 4) { a_ = fmaxf(fmaxf(a_, s0[i]), s0[i + 1]); b_ = fmaxf(fmaxf(b_, s0[i + 2]), s0[i + 3]); a_ = fmaxf(fmaxf(a_, s1[i]), s1[i + 1]); b_ = fmaxf(fmaxf(b_, s1[i + 2]), s1[i + 3]); }
            const float mx = xmax32(fmaxf(a_, b_));
            const float mn = fmaxf(mrow, mx), alpha = __builtin_amdgcn_exp2f(mrow - mn); mrow = mn;
            const unsigned va_ = (unsigned)(size_t)vb_;
            s16x4 la[4], ha[4], lb[4], hb[4];
            SB(); LDV(la, ha, 0); SB();
            float ps = 0.f;
#pragma unroll
            for (int i = 0; i < 16; ++i) { if (!(ABL & 2)) { s0[i] = __builtin_amdgcn_exp2f(s0[i] - mn); s1[i] = __builtin_amdgcn_exp2f(s1[i] - mn); } ps += s0[i] + s1[i]; }
            lsum = lsum * alpha + ps;
            if (__any(alpha != 1.0f)) {
#pragma unroll
                for (int d = 0; d < 4; ++d)
#pragma unroll
                    for (int i = 0; i < 16; ++i) o[d][i] *= alpha; }
            bf16x8 pf[4]; pf[0] = pack8(s0, 0); pf[1] = pack8(s0, 8); pf[2] = pack8(s1, 0); pf[3] = pack8(s1, 8);
            SB(); LDV(lb, hb, 1); LGKM(8); SB(); MMV(la, ha, 0); SB();
            LDV(la, ha, 2); LGKM(8); SB(); MMV(lb, hb, 1); SB();
            LDV(lb, hb, 3); LGKM(8); SB(); MMV(la, ha, 2); SB();
            LGKM(0); SB(); MMV(lb, hb, 3); SB();
        }
        if (t + 1 < NT) { if (t + 2 < NT) AT_WAIT_NEWEST(); else AT_WAITBAR(0); }
        sn2 = sc; sc = (sc == 2) ? 0 : sc + 1;
    }
    lsum = xsum32(lsum);
    const float inv = 1.0f / lsum;
    bf16_t* orow = O + qrow * pO + 4 * h;
#pragma unroll
    for (int d = 0; d < 4; ++d)
#pragma unroll
        for (int g = 0; g < 4; ++g) { u32x2 w; w.x = cvtpk(o[d][4 * g] * inv, o[d][4 * g + 1] * inv); w.y = cvtpk(o[d][4 * g + 2] * inv, o[d][4 * g + 3] * inv); *(u32x2*)(orow + 32 * d + 8 * g) = w; }
#undef AT_ISSUE
#undef AT_WAITBAR
#undef AT_WAIT_NEWEST
#undef SB
#undef LDK
#undef MMK
#undef LDV
#undef MMV
#undef TRR
#undef LGKM
}

DI void gmlp_unit(LAS char* lds, bf16_t* zU, const bf16_t* zV, const float* g_ln, const float* b_ln, const bf16_t* Wb, const float* b_sp, int R0, bool dummy = false) {
    constexpr int WP = 272, VP = 320;
    int tid_ = threadIdx.x; asm volatile("" : "+v"(tid_));
    const int tid = tid_, lane = tid & 63, wid = __builtin_amdgcn_readfirstlane(tid >> 6), r = lane & 31, h = lane >> 5;
    LAS char* Wl = lds; LAS char* Vn = lds + 128 * WP; LAS float* St = (LAS float*)(lds + 128 * WP + 128 * VP);
    __syncthreads();
    { u32x4 rw[16];
#pragma unroll
      for (int i = 0; i < 16; ++i) rw[i] = *(const u32x4*)(zV + (size_t)(R0 + wid * 16 + i) * 512 + lane * 8);
#pragma unroll
      for (int i = 0; i < 16; ++i) { const int s = wid * 16 + i; const u32x4 w = rw[i];
        const float v[8] = {bflo(w.x), bfhi(w.x), bflo(w.y), bfhi(w.y), bflo(w.z), bfhi(w.z), bflo(w.w), bfhi(w.w)};
        float a = 0.f, q = 0.f;
#pragma unroll
        for (int e = 0; e < 8; ++e) { a += v[e]; q += v[e] * v[e]; }
        a = wave_sum(a); q = wave_sum(q);
        const float mu = a * (1.0f / 512.0f), var = fmaxf(q * (1.0f / 512.0f) - mu * mu, 0.f);
        if (lane == 0) { St[2 * s] = mu; St[2 * s + 1] = __builtin_amdgcn_rsqf(var + EPSN); } } }
    const int q4 = (lane & 15) >> 2, p4 = lane & 3, blk = (lane >> 4) & 1, cb = wid & 3, tp = wid >> 2;
    const int lt = tid >> 4, lc8 = (tid & 15) * 8;
    u32x4 pw[4], pv[4]; f32x4 pg[2], pb[2];
#define GM_FETCH(g) do { _Pragma("unroll") for (int i = 0; i < 4; ++i) { pw[i] = *(const u32x4*)(Wb + (size_t)(g) * 16384 + (lt + 32 * i) * 128 + lc8); pv[i] = *(const u32x4*)(zV + (size_t)(R0 + lt + 32 * i) * 512 + (g) * 128 + lc8); } \
        pg[0] = *(const f32x4*)(g_ln + (g) * 128 + lc8); pg[1] = *(const f32x4*)(g_ln + (g) * 128 + lc8 + 4); pb[0] = *(const f32x4*)(b_ln + (g) * 128 + lc8); pb[1] = *(const f32x4*)(b_ln + (g) * 128 + lc8 + 4); } while (0)
    GM_FETCH(0);
#pragma unroll 1
    for (int g = 0; g < 4; ++g) {
        __syncthreads();
#pragma unroll
        for (int i = 0; i < 4; ++i) { const int s = lt + 32 * i;
            *(LAS u32x4*)(Wl + s * WP + lc8 * 2) = pw[i];
            const u32x4 w = pv[i]; float v[8] = {bflo(w.x), bfhi(w.x), bflo(w.y), bfhi(w.y), bflo(w.z), bfhi(w.z), bflo(w.w), bfhi(w.w)};
            const float mu = St[2 * s], rsd = St[2 * s + 1];
#pragma unroll
            for (int e = 0; e < 8; ++e) v[e] = (v[e] - mu) * rsd * pg[e >> 2][e & 3] + pb[e >> 2][e & 3];
            u32x4 o; o.x = cvtpk(v[0], v[1]); o.y = cvtpk(v[2], v[3]); o.z = cvtpk(v[4], v[5]); o.w = cvtpk(v[6], v[7]); *(LAS u32x4*)(Vn + s * VP + lc8 * 2) = o; }
        __syncthreads();
        if (g + 1 < 4) GM_FETCH(g + 1);
        u32x2 uw[2][4]; float bs[2];
#pragma unroll
        for (int tb = 0; tb < 2; ++tb) { const int t = 32 * (2 * tp + tb) + r; bs[tb] = b_sp[g * 128 + t]; const bf16_t* up = zU + (size_t)(R0 + t) * 512 + g * 128 + 32 * cb + 4 * h;
#pragma unroll
            for (int k = 0; k < 4; ++k) uw[tb][k] = *(const u32x2*)(up + 8 * k); }
        f32x16 a0, a1;
#pragma unroll
        for (int i = 0; i < 16; ++i) { a0[i] = 0.f; a1[i] = 0.f; }
        const int tb0 = 2 * tp, tb1 = 2 * tp + 1;
        const LAS char* vb_ = Vn + (8 * h + q4) * VP + cb * 64 + blk * 32 + p4 * 8;
        bf16x8 af[8], b0f[8], b1f[8];
#pragma unroll
        for (int ss = 0; ss < 8; ++ss) {
            if (16 * ss <= 32 * tb1 + 31) {
                const s16x4 lo = vtr(vb_ + (16 * ss) * VP), hi = vtr(vb_ + (16 * ss + 4) * VP);
                af[ss] = (bf16x8){lo[0], lo[1], lo[2], lo[3], hi[0], hi[1], hi[2], hi[3]};
                b1f[ss] = *(const LAS bf16x8*)(Wl + (32 * tb1 + r) * WP + (16 * ss + 8 * h) * 2);
                if (16 * ss <= 32 * tb0 + 31) b0f[ss] = *(const LAS bf16x8*)(Wl + (32 * tb0 + r) * WP + (16 * ss + 8 * h) * 2); } }
        __builtin_amdgcn_sched_barrier(0);
#pragma unroll
        for (int ss = 0; ss < 8; ++ss) {
            if (16 * ss <= 32 * tb1 + 31) { a1 = MFMA32(af[ss], b1f[ss], a1); if (16 * ss <= 32 * tb0 + 31) a0 = MFMA32(af[ss], b0f[ss], a0); } }
#pragma unroll
        for (int tb = 0; tb < 2; ++tb) { const int t = 32 * (2 * tp + tb) + r; bf16_t* up = zU + (size_t)(R0 + t) * 512 + g * 128 + 32 * cb + 4 * h;
#pragma unroll
            for (int k = 0; k < 4; ++k) { const u32x2 u2 = uw[tb][k]; u32x2 w; const f32x16& a = tb ? a1 : a0; const float b_ = bs[tb];
                w.x = cvtpk(bflo(u2.x) * (a[4 * k] + b_), bfhi(u2.x) * (a[4 * k + 1] + b_)); w.y = cvtpk(bflo(u2.y) * (a[4 * k + 2] + b_), bfhi(u2.y) * (a[4 * k + 3] + b_));
                if (dummy) w = u2;
                *(u32x2*)(up + 8 * k) = w; } }
    }
#undef GM_FETCH
}

DI int srccol(int mat, int n) {
    if (mat == 0) { if (n < 1408) return n; if (n < 1472) { const int c = n - 1408; return 1664 + (c & 1) * 32 + (c >> 1); } if (n < 1536) return -1; if (n < 1792) return 1408 + (n - 1536); return n - 64; }
    if (mat == 1) { if (n < 1024) return (n >> 7) * 192 + (n & 127); const int c = n - 1024, hh = c >> 6, cc = c & 63; return hh * 192 + 128 + (cc & 1) * 32 + (cc >> 1); }
    if (mat == 2) { if (n < 1024) return (n >> 7) * 256 + (n & 127); const int c = n - 1024; return (c >> 7) * 256 + 128 + (c & 127); }
    return n;
}
DI void transpose_item(const float* W, const float* gain, int K, int Ns, int Nd, int mat, bf16_t* WT, LAS float* scr, int item, int lane) {
    const int nblk = Nd / 32, kb = item / nblk, nb = item % nblk, k0 = 64 * kb, n0 = 32 * nb;
    const int sc = srccol(mat, n0 + (lane & 31));
#pragma unroll 8
    for (int i = 0; i < 32; ++i) { const int kk = 2 * i + (lane >> 5); float v = 0.f; if (sc >= 0) v = W[(size_t)(k0 + kk) * Ns + sc]; if (gain) v *= gain[k0 + kk]; scr[kk * 33 + (lane & 31)] = v; }
    asm volatile("s_waitcnt lgkmcnt(0)" ::: "memory");
    const int c = lane & 7;
#pragma unroll
    for (int j = 0; j < 4; ++j) { const int n = (lane >> 3) + 8 * j; const LAS float* s = scr + (8 * c) * 33 + n;
        u32x4 o; o.x = cvtpk(s[0 * 33], s[1 * 33]); o.y = cvtpk(s[2 * 33], s[3 * 33]); o.z = cvtpk(s[4 * 33], s[5 * 33]); o.w = cvtpk(s[6 * 33], s[7 * 33]);
        *(u32x4*)(WT + (size_t)(n0 + n) * K + k0 + 8 * c) = o; }
    asm volatile("s_waitcnt lgkmcnt(0)" ::: "memory");
}
template <int NR> DI void rows_to_bf16(const float* x0, bf16_t* o0, float* rstd0, int rstride, int nvalid, int lane) {
    f32x4 v[NR][4];
#pragma unroll
    for (int r = 0; r < NR; ++r) { const f32x4* xr = (const f32x4*)(x0 + (size_t)(r < nvalid ? r : 0) * rstride * 1024) + lane;
#pragma unroll
        for (int j = 0; j < 4; ++j) v[r][j] = xr[64 * j]; }
#pragma unroll
    for (int r = 0; r < NR; ++r) { if (r >= nvalid) break; float s = 0.f;
#pragma unroll
        for (int j = 0; j < 4; ++j) s += (v[r][j][0] * v[r][j][0] + v[r][j][1] * v[r][j][1]) + (v[r][j][2] * v[r][j][2] + v[r][j][3] * v[r][j][3]);
        s = wave_sum(s);
        u32x2* o8 = (u32x2*)(o0 + (size_t)r * rstride * 1024) + lane;
#pragma unroll
        for (int j = 0; j < 4; ++j) { u32x2 w; w.x = cvtpk(v[r][j][0], v[r][j][1]); w.y = cvtpk(v[r][j][2], v[r][j][3]); o8[64 * j] = w; }
        if (lane == 0) rstd0[(size_t)r * rstride] = __builtin_amdgcn_rsqf(s * (1.0f / 1024.0f) + EPSN); }
}


#define RLX_AGENT __ATOMIC_RELAXED, __HIP_MEMORY_SCOPE_AGENT
#define XB_TMO      128
#define XB_XCNT(j)  (256  + 64 * (j))
#define XB_XSUB(j)  (1280 + 64 * (j))
#define XB_XGEN(j)  (2304 + 64 * (j))
#define XB_TOP      3328
#define XB_TOPGEN   3392
#define XCD_BAR_WORDS 3456
#define XB_SPIN_CAP (1u << 18)

__device__ __forceinline__ unsigned xb_ld(unsigned* p)              { return __hip_atomic_load(p, __ATOMIC_RELAXED, __HIP_MEMORY_SCOPE_AGENT); }
__device__ __forceinline__ unsigned xb_add(unsigned* p, unsigned v) { return __hip_atomic_fetch_add(p, v, __ATOMIC_RELAXED, __HIP_MEMORY_SCOPE_AGENT); }
__device__ __forceinline__ unsigned xb_xcc_id() { return (unsigned)__builtin_amdgcn_s_getreg((3 << 11) | 20) & 0xFu; }
#define XB_SPIN(cond, bar) do { unsigned _sp = 0; while (cond) { __builtin_amdgcn_s_sleep(1); \
    if ((++_sp & 255u) == 0u) { if (xb_ld(&(bar)[XB_TMO])) break; if (_sp > XB_SPIN_CAP) { atomicAdd(&(bar)[XB_TMO], 1u); break; } } } } while (0)

struct XcdBarrier {
    unsigned* bar; unsigned x;
    volatile LAS unsigned* st;
};

__device__ __forceinline__ XcdBarrier xcd_barrier_post(unsigned* bar, volatile LAS unsigned* st) {
    XcdBarrier b; b.bar = bar; b.x = xb_xcc_id(); b.st = st;
    if (threadIdx.x == 0) (void)xb_add(&bar[XB_XCNT(b.x)], 1u);
    return b;
}
__device__ __forceinline__ void xcd_barrier_complete(unsigned* bar, unsigned x, unsigned& nloc, unsigned& nx) {
    const unsigned G = gridDim.x * gridDim.y * gridDim.z;
    unsigned sum, cnt, mine, sp = 0u;
    for (;;) {
        sum = 0u; cnt = 0u; mine = 0u;
#pragma unroll
        for (unsigned j = 0; j < 16; ++j) { const unsigned c = xb_ld(&bar[XB_XCNT(j)]); sum += c; cnt += (c > 0u) ? 1u : 0u; mine = (j == x) ? c : mine; }
        if (sum == G) break;
        __builtin_amdgcn_s_sleep(1);
        if ((++sp & 255u) == 0u) { if (xb_ld(&bar[XB_TMO])) break; if (sp > XB_SPIN_CAP) { atomicAdd(&bar[XB_TMO], 1u); break; } }
    }
    nloc = mine > 0u ? mine : 1u; nx = cnt > 0u ? cnt : 1u;
}

__device__ __forceinline__ void xcd_barrier(const XcdBarrier& b) {
    asm volatile("s_waitcnt vmcnt(0)" ::: "memory");
    __syncthreads();
    if (threadIdx.x == 0) {
        unsigned* bar = b.bar;
        __builtin_amdgcn_s_waitcnt(0);
        unsigned nloc = b.st[0], nx = b.st[1];
        if (nloc == 0u) { xcd_barrier_complete(bar, b.x, nloc, nx); b.st[0] = nloc; b.st[1] = nx; }
        const unsigned old = xb_add(&bar[XB_XSUB(b.x)], 1u);
        const unsigned gen = old / nloc;
        if (old + 1u == (gen + 1u) * nloc) {
            __builtin_amdgcn_fence(__ATOMIC_RELEASE, "agent");
            asm volatile("s_waitcnt vmcnt(0)" ::: "memory");
            const unsigned og = xb_add(&bar[XB_TOP], 1u);
            const unsigned tg = og / nx;
            if (og + 1u == (tg + 1u) * nx) xb_add(&bar[XB_TOPGEN], 1u);
            else XB_SPIN(xb_ld(&bar[XB_TOPGEN]) == tg, bar);
            __builtin_amdgcn_fence(__ATOMIC_ACQUIRE, "agent");
            xb_add(&bar[XB_XGEN(b.x)], 1u);
            asm volatile("s_waitcnt vmcnt(0)" ::: "memory");
        } else {
            XB_SPIN(xb_ld(&bar[XB_XGEN(b.x)]) == gen, bar);
            __builtin_amdgcn_fence(__ATOMIC_ACQUIRE, "agent");
            asm volatile("s_waitcnt vmcnt(0)" ::: "memory");
        }
    }
    __syncthreads();
}

struct Args { const float* in[28]; float* out; unsigned char* ws; };

typedef const __attribute__((address_space(4))) Args* KArgP;
DI Bag make_bag(KArgP kp, LAS unsigned char* lds) {
    unsigned char* ws = kp->ws; Bag b;
    b.x = kp->in[0]; b.g_qn = kp->in[9]; b.g_qp = kp->in[10]; b.g_kn = kp->in[11]; b.g_kp = kp->in[12]; b.g_mq = kp->in[19]; b.g_mk = kp->in[20];
    b.rstd_x = (float*)(ws + S_RSX); b.rstd_mem = (float*)(ws + S_RSM); b.ssq_cq = (float*)(ws + S_SSQCQ); b.ssq_ckv = (float*)(ws + S_SSQCKV); b.ssq2 = (float*)(ws + S_SSQ2); b.rope = (const float*)(ws + S_ROPE);
    b.zU = (bf16_t*)(ws + A_ZU); b.zV = (bf16_t*)(ws + A_ZV); b.zCQ = (bf16_t*)(ws + A_ZCQ); b.zCKV = (bf16_t*)(ws + A_ZCKV); b.zQM = (bf16_t*)(ws + A_ZQM); b.zG = (bf16_t*)(ws + A_ZG);
    b.q = (bf16_t*)(ws + A_Q); b.kv = (bf16_t*)kp->out; b.memkv = (bf16_t*)(ws + A_MEMKV); b.merged = (bf16_t*)kp->out; b.x1b = (bf16_t*)(ws + A_X1B); b.hdn = (bf16_t*)(ws + A_HDN);
    b.x1 = (float*)(ws + A_X1); b.out = kp->out; b.P = (LAS float*)(lds + P_OFF);
    return b;
}
#define WSP(off) ((bf16_t*)(kp->ws + (off)))
#define FRESH() asm volatile("" : "+s"(kp))
#ifndef PHM
#define PHM 0xff
#endif
#ifndef P2M
#define P2M 15
#endif
__global__ void __launch_bounds__(512) mega_fwd(Args a_unused) {
    extern __shared__ __attribute__((aligned(16))) unsigned char lds_raw[];
    cg::grid_group grid = cg::this_grid();
    LAS unsigned char* lds = (LAS unsigned char*)lds_raw;
    const int tid = threadIdx.x, lane = tid & 63, wave = __builtin_amdgcn_readfirstlane(tid >> 6), G = gridDim.x, bid = blockIdx.x;
    KArgP kp = (KArgP)__builtin_amdgcn_kernarg_segment_ptr();
    (void)a_unused;
    volatile LAS unsigned* bst = (volatile LAS unsigned*)(lds + P_OFF + 8192);
    if (tid == 0) { bst[0] = 0u; bst[1] = 0u; }
    if (bid == 0) { unsigned* bw = (unsigned*)(kp->ws + S_BAR); for (int i = tid; i < XCD_BAR_WORDS; i += 512) __hip_atomic_store(bw + i, 0u, RLX_AGENT); }
    __syncthreads();

#ifndef REP_P0
#define REP_P0 1
#endif
#ifndef REP_P6
#define REP_P6 1
#endif
#pragma unroll 1
    for (int rep0 = 0; rep0 < REP_P0; ++rep0) {
        FRESH();
        unsigned char* ws = kp->ws;
        LAS float* scr = (LAS float*)(lds + wave * 16384);
        const int gw = bid * 8 + wave, NGW = G * 8;
        constexpr int I0 = 16 * 168, I1 = 6 * 48, I2 = 4 * 64, I3 = 16 * 32, I4 = 8 * 32, I5 = 16 * 32, I6 = 8 * 32, I7 = 16 * 32, I8 = 16 * 128, I9 = 64 * 32;
        constexpr int NIT = I0 + I1 + I2 + I3 + I4 + I5 + I6 + I7;
        for (int it = gw; it < NIT; it += NGW) {
            int r = it;
            if (r < I0) { transpose_item(kp->in[4], kp->in[3], 1024, 5312, 5376, 0, WSP(W_IN), scr, r, lane); continue; } r -= I0;
            if (r < I1) { transpose_item(kp->in[6], kp->in[5], 384, 1536, 1536, 1, WSP(W_UQ), scr, r, lane); continue; } r -= I1;
            if (r < I2) { transpose_item(kp->in[8], kp->in[7], 256, 2048, 2048, 2, WSP(W_UKV), scr, r, lane); continue; } r -= I2;
            if (r < I3) { transpose_item(kp->in[18], kp->in[17], 1024, 1024, 1024, 3, WSP(W_MKV), scr, r, lane); continue; } r -= I3;
            if (r < I4) { transpose_item(kp->in[21], nullptr, 512, 1024, 1024, 3, WSP(W_OGM), scr, r, lane); continue; } r -= I4;
            if (r < I5) { transpose_item(kp->in[22], nullptr, 1024, 1024, 1024, 3, WSP(W_OMLA), scr, r, lane); continue; } r -= I5;
            if (r < I6) { transpose_item(kp->in[23], nullptr, 512, 1024, 1024, 3, WSP(W_OMEM), scr, r, lane); continue; } r -= I6;
            transpose_item(kp->in[24], nullptr, 1024, 1024, 1024, 3, WSP(W_WOUT), scr, r, lane);
        }
        { const float* x = kp->in[0]; bf16_t* xb = WSP(A_XB); float* rsx = (float*)(ws + S_RSX);
          for (int m = gw; m < T; m += 4 * NGW) rows_to_bf16<4>(x + (size_t)m * 1024, xb + (size_t)m * 1024, rsx + m, NGW, (T - 1 - m) / NGW + 1, lane); }
        { const float* mem = kp->in[1]; bf16_t* memb = WSP(A_MEMB); float* rsm = (float*)(ws + S_RSM);
          for (int m = gw; m < MEMT; m += 4 * NGW) rows_to_bf16<4>(mem + (size_t)m * 1024, memb + (size_t)m * 1024, rsm + m, NGW, (MEMT - 1 - m) / NGW + 1, lane); }
        { const float* wsp = kp->in[15]; bf16_t* wb = WSP(S_WSP);
          for (int idx = bid * 512 + tid; idx < 4 * 128 * 128 / 2; idx += G * 512) { const int e = idx * 2, t = (e >> 7) & 127, sc = e & 127; const f32x2_t w = *(const f32x2_t*)(wsp + e);
              *(unsigned*)(wb + e) = cvtpk(sc <= t ? w[0] : 0.f, sc + 1 <= t ? w[1] : 0.f); } }
        { float* z1 = (float*)(ws + S_SSQCQ); float* z2 = (float*)(ws + S_SSQCKV); float* z3 = (float*)(ws + S_SSQ2);
          for (int i = bid * 512 + tid; i < T; i += G * 512) { z1[i] = 0.f; z2[i] = 0.f; z3[i] = 0.f; } }
        float* rope = (float*)(ws + S_ROPE); const int* pos = (const int*)kp->in[2];
        for (int idx = bid * 512 + tid; idx < T * 32; idx += G * 512) { const int row = idx >> 5, p = idx & 31;
            const float invf = exp2f(-(float)(2 * p) * (13.287712379549449f / 64.0f)); const float ang = (float)pos[row] * invf;
            const double rev = (double)ang * 0.15915494309189535; const float fr_ = (float)(rev - __builtin_rint(rev));
            rope[2 * (size_t)idx] = __builtin_amdgcn_cosf(fr_); rope[2 * (size_t)idx + 1] = __builtin_amdgcn_sinf(fr_); }
    }
    grid.sync();
    const XcdBarrier xbar = xcd_barrier_post((unsigned*)(kp->ws + S_BAR), bst);
    if (PHM & 2) {
#ifndef REP_P1
#define REP_P1 1
#endif
#pragma unroll 1
        for (int r1 = 0; r1 < REP_P1; ++r1) { FRESH(); Bag b = make_bag(kp, lds);
          if (REP_P1 > 1 && r1 + 1 < REP_P1) { b.ssq_cq = (float*)(kp->ws + 48 * MiB); b.ssq_ckv = (float*)(kp->ws + 49 * MiB); }
          pg8::Gemm g{WSP(A_XB), WSP(W_IN), T, 5376, 1024, 1024}; pg8::StaticOrder S; S.init(T, 5376, G, bid); Epi<K_Z> E{b, 0};
          pg8::gemm_phase<Epi<K_Z>, pg8::StaticOrder, true, true, 1024, 1024>(lds, g, S, E); }
        { const int c2 = (bid + 128) % G;
          if (G <= 128 || c2 >= 128) { FRESH(); __syncthreads();
            LAS float* scr = (LAS float*)(lds + wave * 16384);
            const int rank = (G > 128) ? c2 - 128 : bid, nidle = (G > 128) ? G - 128 : G;
            constexpr int I8 = 16 * 128, I9 = 64 * 32;
            for (int it = rank * 8 + wave; it < I8 + I9; it += nidle * 8) {
                if (it < I8) transpose_item(kp->in[26], kp->in[25], 1024, 4096, 4096, 3, WSP(W_FF1), scr, it, lane);
                else transpose_item(kp->in[27], nullptr, 4096, 1024, 1024, 3, WSP(W_FF2), scr, it - I8, lane); }
            __syncthreads(); } }
        { FRESH(); const Bag b = make_bag(kp, lds);
          pg8::Gemm g2{WSP(A_MEMB), WSP(W_MKV), MEMT, 1024, 1024, 1024}; pg8::StaticOrder S2; S2.init(MEMT, 1024, G, (bid + 128) % G); Epi<K_MEMKV> E2{b, 0};
          pg8::gemm_phase<Epi<K_MEMKV>, pg8::StaticOrder, true, true, 1024, 1024>(lds, g2, S2, E2); }
    }
    xcd_barrier(xbar);
    if (PHM & 4) {
#pragma unroll 1
      for (int k2 = 0; k2 < 2; ++k2) { const int part = (bid & 1) ? 1 - k2 : k2;
      if (part == 0) {
#ifndef REP_P2G
#define REP_P2G 1
#endif
#ifndef REP_GM
#define REP_GM 1
#endif
#pragma unroll 1
        for (int rg = 0; rg < REP_P2G; ++rg) {
        if (P2M & 1) { FRESH(); const Bag b = make_bag(kp, lds);
          pg8::Gemm g{b.zCQ, WSP(W_UQ), T, 1536, 384, 512}; pg8::StaticOrder S; S.init(T, 1536, G, bid); Epi<K_Q> E{b, 0};
          pg8::gemm_phase<Epi<K_Q>, pg8::StaticOrder, true, true, 384, 512>(lds, g, S, E); }
        if (P2M & 2) { FRESH(); const Bag b = make_bag(kp, lds);
          pg8::Gemm g2{b.zCKV, WSP(W_UKV), T, 2048, 256, 256}; pg8::StaticOrder S2; S2.init(T, 2048, G, bid); Epi<K_KV> E2{b, 0};
          pg8::gemm_phase<Epi<K_KV>, pg8::StaticOrder, true, true, 256, 256>(lds, g2, S2, E2); }
        }
      } else {
        __syncthreads();
        if (P2M & 4) { FRESH();
#pragma unroll 1
          for (int u = bid; u < 512 * REP_GM; u += G) gmlp_unit((LAS char*)lds, WSP(A_ZU), WSP(A_ZV), kp->in[13], kp->in[14], WSP(S_WSP), kp->in[16], (u & 511) * 128, REP_GM > 1 && u < 512 * (REP_GM - 1)); }
        if (P2M & 8) { FRESH(); bf16_t* zQM = WSP(A_ZQM); const bf16_t* memkv = WSP(A_MEMKV);
#pragma unroll 1
          for (int u0 = bid; u0 < 1024; u0 += G) { int u = u0;
            if (G == 256) { const int L = (u0 >> 8) * 32 + (bid >> 3); u = ((L >> 3) * 8 + (bid & 7)) * 8 + (L & 7); }
            const int bb = u >> 5, hh = (u >> 3) & 3, qb = u & 7;
            bf16_t* Q = zQM + (size_t)bb * SEQ * 512 + hh * 128; const bf16_t* Kp = memkv + (size_t)bb * MEML * 1024 + hh * 128;
            attn_unit<128, false>((LAS char*)lds, Q, 512, nullptr, 0, Kp, 1024, nullptr, 0, Kp + 512, 1024, Q, 512, qb * 256, 4); } }
      }
      __syncthreads();
      }
    }
    xcd_barrier(xbar);
    if (PHM & 8) {
        FRESH(); bf16_t* q = WSP(A_Q); const bf16_t* kv = (const bf16_t*)kp->out; const bf16_t* zCQ = WSP(A_ZCQ);
#ifndef REP_P3
#define REP_P3 1
#endif
#pragma unroll 1
        for (int it = bid; it < 1024 * REP_P3; it += G) { int bh = it & 255, pr = (it >> 8) & 3;
            if (G == 256) { bh = ((bid & 7) + 8 * (bid >> 5)) + 64 * ((it >> 8) & 3); pr = (bid >> 3) & 3; }
            const int bb = bh >> 3, hh = bh & 7;
            bf16_t* Qa = q + (size_t)bb * SEQ * 1536 + hh * 128; const bf16_t* Qb = q + (size_t)bb * SEQ * 1536 + 1024 + hh * 64;
            const bf16_t* Ka = kv + (size_t)bb * SEQ * 2048 + hh * 128; const bf16_t* Kb = zCQ + (size_t)bb * SEQ * 512 + 384; const bf16_t* Vp = Ka + 1024;
            bf16_t* Op = Qa; int pO = 1536;
            if (REP_P3 > 1 && it < 1024 * (REP_P3 - 1)) { Op = WSP(A_ZV) + (size_t)bb * SEQ * 512 + (hh & 3) * 128; pO = 512; }
#pragma unroll 1
            for (int k = 0; k < 2; ++k) { const int qb = k ? 7 - pr : pr;
#if defined(P3ABL)
                if (REP_P3 > 1 && it < 1024 * (REP_P3 - 1)) attn_unit<192, true, P3ABL>((LAS char*)lds, Qa, 1536, Qb, 1536, Ka, 2048, Kb, 512, Vp, 2048, Op, pO, qb * 256, 4 * (qb + 1)); else
#endif
                attn_unit<192, true>((LAS char*)lds, Qa, 1536, Qb, 1536, Ka, 2048, Kb, 512, Vp, 2048, Op, pO, qb * 256, 4 * (qb + 1)); } }
    }
    xcd_barrier(xbar);
    if (PHM & 16) {
        pg8::StaticOrder S; S.init(T, 1024, G, bid);
#ifndef REP_P4
#define REP_P4 1
#endif
#pragma unroll 1
        for (int r4 = 0; r4 < REP_P4; ++r4) {
#pragma unroll 1
        for (int k = 0; k < 3; ++k) {
            const int brn = (k == 2) ? 2 : ((bid & 1) ? 1 - k : k), fl = brn | ((k > 0) << 8);
            FRESH(); const Bag b = make_bag(kp, lds); Epi<K_OUT> E{b, fl};
            if (brn == 1) { pg8::Gemm g{b.q, WSP(W_OMLA), T, 1024, 1024, 1536}; pg8::gemm_phase<Epi<K_OUT>, pg8::StaticOrder, true, true, 1024, 1536>(lds, g, S, E); }
            else { pg8::Gemm g{brn == 0 ? b.zU : b.zQM, brn == 0 ? WSP(W_OGM) : WSP(W_OMEM), T, 1024, 512, 512}; pg8::gemm_phase<Epi<K_OUT>, pg8::StaticOrder, true, true, 512, 512>(lds, g, S, E); }
        }
        }
    }
    xcd_barrier(xbar);
#ifndef REP_P5
#define REP_P5 1
#endif
#pragma unroll 1
    for (int r5 = 0; r5 < REP_P5; ++r5) { FRESH(); Bag b = make_bag(kp, lds); if (REP_P5 > 1 && r5 + 1 < REP_P5) b.ssq2 = (float*)(kp->ws + 48 * MiB); pg8::Gemm g{b.merged, WSP(W_WOUT), T, 1024, 1024, 1024}; pg8::StaticOrder S; S.init(T, 1024, G, bid); Epi<K_WOUT> E{b, 0}; pg8::gemm_phase<Epi<K_WOUT>, pg8::StaticOrder, true, true, 1024, 1024>(lds, g, S, E); }
    xcd_barrier(xbar);
#pragma unroll 1
    for (int rep6 = 0; rep6 < REP_P6; ++rep6) { FRESH(); const Bag b = make_bag(kp, lds); pg8::Gemm g{b.x1b, WSP(W_FF1), T, 4096, 1024, 1024}; pg8::StaticOrder S; S.init(T, 4096, G, bid); Epi<K_FF1> E{b, 0}; pg8::gemm_phase<Epi<K_FF1>, pg8::StaticOrder, true, true, 1024, 1024>(lds, g, S, E); }
    xcd_barrier(xbar);
#ifndef REP_P7
#define REP_P7 1
#endif
#pragma unroll 1
    for (int r7 = 0; r7 < REP_P7; ++r7) { FRESH(); const Bag b = make_bag(kp, lds); pg8::Gemm g{b.hdn, WSP(W_FF2), T, 1024, 4096, 4096}; pg8::StaticOrder S; S.init(T, 1024, G, bid); Epi<K_FF2> E{b, 0}; pg8::gemm_phase<Epi<K_FF2>, pg8::StaticOrder, true, true, 4096, 4096>(lds, g, S, E); }
}

extern "C" void kernel_launch(void* const* d_in, const int* in_sizes, int n_in, void* d_out, int out_size, void* d_ws, size_t ws_size, hipStream_t stream) {
    static int grid_blocks = 0;
    if (grid_blocks == 0) {
        if (n_in != 28 || ws_size < WS_NEED) { fprintf(stderr, "kernel_launch: need 28 inputs and %zu bytes of workspace (got %d, %zu)\n", (size_t)WS_NEED, n_in, ws_size); grid_blocks = -1; return; }
        int dev = 0, cus = 0, per_cu = 0;
        hipGetDevice(&dev); hipDeviceGetAttribute(&cus, hipDeviceAttributeMultiprocessorCount, dev);
        if (hipFuncSetAttribute((const void*)mega_fwd, hipFuncAttributeMaxDynamicSharedMemorySize, LDS_BYTES) != hipSuccess) { fprintf(stderr, "kernel_launch: hipFuncSetAttribute failed\n"); grid_blocks = -1; return; }
        if (hipOccupancyMaxActiveBlocksPerMultiprocessor(&per_cu, (const void*)mega_fwd, 512, LDS_BYTES) != hipSuccess || per_cu < 1) { fprintf(stderr, "kernel_launch: occupancy query gave %d\n", per_cu); per_cu = 1; }
        (void)hipGetLastError();
        grid_blocks = cus * (per_cu > 1 ? 1 : per_cu);
    }
    if (grid_blocks < 0) return;
    Args a{};
    for (int i = 0; i < 28; ++i) a.in[i] = (const float*)d_in[i];
    a.out = (float*)d_out; a.ws = (unsigned char*)d_ws;
    void* args[] = {&a};
    hipError_t e = hipLaunchCooperativeKernel((const void*)mega_fwd, dim3(grid_blocks), dim3(512), args, LDS_BYTES, stream);
    if (e != hipSuccess) fprintf(stderr, "cooperative launch failed: %s (grid %d)\n", hipGetErrorString(e), grid_blocks);
}
```

```cpp
#include <hip/hip_runtime.h>
#include <hip/hip_cooperative_groups.h>
#include <cstdio>
#include <cstdint>
namespace cg = cooperative_groups;
namespace pg8 {
#define PG8_LAS __attribute__((address_space(3)))
typedef unsigned short bf16_t;
typedef short bf16x8 __attribute__((ext_vector_type(8)));
typedef float f32x4 __attribute__((ext_vector_type(4)));
typedef unsigned u32x4 __attribute__((ext_vector_type(4)));
constexpr int BM = 256, BK = 64, HALF = 128, HTB = HALF * BK * 2  , STAGE_BYTES = 8 * HTB, NXCD = 8, WGM = 8;

__host__ __device__ __forceinline__ int lds_byte(int r, int c) { const int st = (r >> 4) * 2 + (c >> 5), rr = r & 15, cc = c & 31, ob = rr * 64 + cc * 2; return st * 1024 + (ob ^ (((ob >> 9) & 1) << 5)); }
__host__ __device__ __forceinline__ void stage_rc(int b, int& R, int& C) { const int st = b / 1024, sb = b % 1024, swz = sb ^ (((sb >> 9) & 1) << 5); R = (st >> 1) * 16 + swz / 64; C = (st & 1) * 32 + (swz % 64) / 2; }
__host__ __device__ __forceinline__ int perm32(int rho) { const int n = rho >> 4, i = rho & 15; return 8 * (i >> 2) + 4 * n + (i & 3); }

struct Unit { int pm, pn; };
struct Gemm { const bf16_t* A; const bf16_t* Bt; int M, N, K, lda; };

struct StaticOrder {
    int nM, nN, nwg, G, c;
    __host__ __device__ void init(int M, int N, int G_, int c_) { nM = M / BM; nN = N / BM; nwg = nM * nN; G = G_; c = c_; }
    __host__ __device__ bool next(int i, Unit& u) const {
        const long L = (long)i * G + c; if (L >= nwg) return false;
        int wgid = (int)L; { const int q = nwg / NXCD, r = nwg % NXCD, xcd = wgid % NXCD, off = wgid / NXCD; wgid = (xcd < r ? xcd * (q + 1) : r * (q + 1) + (xcd - r) * q) + off; }
        const int nig = WGM * nN, gid = wgid / nig, fm = gid * WGM, gsz = (nM - fm) < WGM ? (nM - fm) : WGM;
        u.pm = fm + ((wgid % nig) % gsz); u.pn = (wgid % nig) / gsz; return true;
    }
    __device__ __forceinline__ void a_ready(const Unit&) const {}
    __device__ __forceinline__ void done(const Unit&) const {}
};

template <class Epi, class Sched, bool ALIGN_EPI = false, bool SP2 = false, int KC = 0, int LDAC = 0>
__device__ __forceinline__ void gemm_phase(PG8_LAS unsigned char* lds, const Gemm g, const Sched& S, const Epi& E) {
    int tid_ = threadIdx.x; asm volatile("" : "+v"(tid_));
    const int tid = tid_, wid = __builtin_amdgcn_readfirstlane(tid >> 6), lane = tid & 63, wr = wid >> 2, wc = wid & 3, fr = lane & 15, fq = lane >> 4;
    const int K = KC ? KC : g.K, nt = K / BK, lda_ = LDAC ? LDAC : g.lda;
    unsigned voffA[2], voffB[2];
#pragma unroll
    for (int i = 0; i < 2; ++i) { int R, C; stage_rc(tid * 16 + i * 8192, R, C); const int Rb = Epi::PERM ? ((R & ~31) + perm32(R & 31)) : R;
        voffA[i] = (unsigned)(R * lda_ + C) * 2u; voffB[i] = (unsigned)(Rb * K + C) * 2u; }
    const size_t kstep = (size_t)(BK * 2);
    const size_t hstepA = (size_t)HALF * lda_ * 2, hstepB = (size_t)HALF * K * 2;
    const size_t tstepA = 2 * hstepA, tstepB = 2 * hstepB;
    const unsigned ldsw = (unsigned)wid * 1024u;
    const int aoff = lds_byte(wr * 64 + fr, fq * 8), boff = lds_byte(wc * 32 + fr, fq * 8);
#define PG8_SA(b, h) (((b) * 2 + (h)) * HTB)
#define PG8_SB(b, h) ((4 + (b) * 2 + (h)) * HTB)
#define PG8_STAGE(bufoff, gbase, voff) do { _Pragma("unroll") for (int _i = 0; _i < 2; ++_i) \
        __builtin_amdgcn_global_load_lds((const unsigned*)((const char*)(gbase) + (voff)[_i]), (PG8_LAS unsigned*)(lds + (bufoff) + ldsw + _i * 8192), 16, 0, 0); } while (0)
#define PG8_LDA(dst, b, h) do { _Pragma("unroll") for (int m = 0; m < 4; ++m) _Pragma("unroll") for (int k = 0; k < 2; ++k) dst[m][k] = *(const PG8_LAS bf16x8*)(lds + PG8_SA(b, h) + aoff + m * 2048 + k * 1024); } while (0)
#define PG8_LDB(dst, b, h) do { _Pragma("unroll") for (int n = 0; n < 2; ++n) _Pragma("unroll") for (int k = 0; k < 2; ++k) dst[n][k] = *(const PG8_LAS bf16x8*)(lds + PG8_SB(b, h) + boff + n * 2048 + k * 1024); } while (0)
#define PG8_MMA(ai, bj, At, Bt) do { __builtin_amdgcn_s_setprio(1); _Pragma("unroll") for (int m = 0; m < 4; ++m) _Pragma("unroll") for (int n = 0; n < 2; ++n) _Pragma("unroll") for (int k = 0; k < 2; ++k) \
        acc[ai][bj][m][n] = __builtin_amdgcn_mfma_f32_16x16x32_bf16(Bt[n][k], At[m][k], acc[ai][bj][m][n], 0, 0, 0); __builtin_amdgcn_s_setprio(0); } while (0)
#define PG8_WAIT_V(n) asm volatile("s_waitcnt vmcnt(" #n ")" ::: "memory")
#define PG8_WAIT_L(n) asm volatile("s_waitcnt lgkmcnt(" #n ")" ::: "memory")
#define PG8_BAR __builtin_amdgcn_s_barrier()
#define PG8_SCHED __builtin_amdgcn_sched_barrier(0)
    Unit cur, nxt; int ui = 0;
    if (!S.next(0, cur)) return;
    f32x4 acc[2][2][4][2];
#pragma unroll
    for (int a = 0; a < 2; ++a)
#pragma unroll
        for (int b = 0; b < 2; ++b)
#pragma unroll
            for (int m = 0; m < 4; ++m)
#pragma unroll
                for (int n = 0; n < 2; ++n) acc[a][b][m][n] = (f32x4){0.f, 0.f, 0.f, 0.f};
    bf16x8 At[4][2], B0[2][2], B1[2][2];
    const char* cA = (const char*)g.A + (size_t)cur.pm * tstepA; const char* cB = (const char*)g.Bt + (size_t)cur.pn * tstepB;
    S.a_ready(cur);
    if constexpr (SP2) {
        PG8_STAGE(PG8_SB(0, 0), cB, voffB); PG8_STAGE(PG8_SB(0, 1), cB + hstepB, voffB); PG8_STAGE(PG8_SA(0, 0), cA, voffA); PG8_STAGE(PG8_SA(0, 1), cA + hstepA, voffA);
        if (wr == 1) PG8_BAR;
        PG8_WAIT_V(2); PG8_BAR;
        PG8_STAGE(PG8_SB(1, 0), cB + kstep, voffB); PG8_STAGE(PG8_SA(1, 0), cA + kstep, voffA); PG8_STAGE(PG8_SB(1, 1), cB + hstepB + kstep, voffB);
        PG8_WAIT_V(6); PG8_BAR;
    } else {
        PG8_STAGE(PG8_SB(0, 0), cB, voffB); PG8_STAGE(PG8_SA(0, 0), cA, voffA); PG8_STAGE(PG8_SB(0, 1), cB + hstepB, voffB); PG8_STAGE(PG8_SA(0, 1), cA + hstepA, voffA);
        if (wr == 1) PG8_BAR;
        PG8_WAIT_V(4); PG8_BAR;
        PG8_STAGE(PG8_SB(1, 0), cB + kstep, voffB); PG8_STAGE(PG8_SA(1, 0), cA + kstep, voffA); PG8_STAGE(PG8_SB(1, 1), cB + hstepB + kstep, voffB);
        PG8_WAIT_V(6); PG8_BAR;
    }
    for (;;) {
        const bool has_next = S.next(ui + 1, nxt);
        const char* nA = has_next ? (const char*)g.A + (size_t)nxt.pm * tstepA : cA; const char* nB = has_next ? (const char*)g.Bt + (size_t)nxt.pn * tstepB : cB;
#pragma unroll 1
        for (int t = 0; t < nt; t += 2) {
            const bool last = (t == nt - 2);
            const char* a1 = cA + (size_t)(t + 1) * kstep;
            const char* a2 = last ? nA : cA + (size_t)(t + 2) * kstep; const char* b2 = last ? nB : cB + (size_t)(t + 2) * kstep;
            const char* a3 = a2 + kstep; const char* b3 = b2 + kstep;
            if (last && has_next) S.a_ready(nxt);
            if constexpr (SP2) {
            PG8_LDB(B0, 0, 0); PG8_LDB(B1, 0, 1); PG8_SCHED; PG8_LDA(At, 0, 0); PG8_STAGE(PG8_SA(1, 1), a1 + hstepA, voffA);
            PG8_WAIT_V(8); PG8_WAIT_L(0); PG8_BAR; PG8_MMA(0, 0, At, B0); PG8_MMA(0, 1, At, B1); PG8_BAR; PG8_SCHED;
            PG8_LDA(At, 0, 1); PG8_STAGE(PG8_SB(0, 0), b2, voffB); PG8_STAGE(PG8_SB(0, 1), b2 + hstepB, voffB); PG8_STAGE(PG8_SA(0, 0), a2, voffA);
            PG8_WAIT_V(8); PG8_WAIT_L(0); PG8_BAR; PG8_MMA(1, 0, At, B0); PG8_MMA(1, 1, At, B1); PG8_BAR; PG8_SCHED;
            PG8_LDB(B0, 1, 0); PG8_LDB(B1, 1, 1); PG8_SCHED; PG8_LDA(At, 1, 0); PG8_STAGE(PG8_SA(0, 1), a2 + hstepA, voffA);
            PG8_WAIT_V(8); PG8_WAIT_L(0); PG8_BAR; PG8_MMA(0, 0, At, B0); PG8_MMA(0, 1, At, B1); PG8_BAR; PG8_SCHED;
            PG8_LDA(At, 1, 1); PG8_STAGE(PG8_SB(1, 0), b3, voffB); PG8_STAGE(PG8_SB(1, 1), b3 + hstepB, voffB); PG8_STAGE(PG8_SA(1, 0), a3, voffA);
            PG8_WAIT_V(8); PG8_WAIT_L(0); PG8_BAR; PG8_MMA(1, 0, At, B0); PG8_MMA(1, 1, At, B1); PG8_BAR; PG8_SCHED;
            } else {
            PG8_LDB(B0, 0, 0); PG8_SCHED; PG8_LDA(At, 0, 0); PG8_STAGE(PG8_SA(1, 1), a1 + hstepA, voffA);
            PG8_WAIT_L(8); PG8_BAR; PG8_WAIT_L(0); PG8_MMA(0, 0, At, B0); PG8_BAR; PG8_SCHED;
            PG8_LDB(B1, 0, 1); PG8_STAGE(PG8_SB(0, 0), b2, voffB);
            PG8_BAR; PG8_WAIT_L(0); PG8_MMA(0, 1, At, B1); PG8_BAR;
            PG8_LDA(At, 0, 1); PG8_STAGE(PG8_SA(0, 0), a2, voffA);
            PG8_BAR; PG8_WAIT_L(0); PG8_MMA(1, 0, At, B0); PG8_BAR; PG8_SCHED;
            PG8_STAGE(PG8_SB(0, 1), b2 + hstepB, voffB);
            PG8_WAIT_V(6); PG8_BAR; PG8_MMA(1, 1, At, B1); PG8_BAR;
            PG8_LDB(B0, 1, 0); PG8_SCHED; PG8_LDA(At, 1, 0); PG8_STAGE(PG8_SA(0, 1), a2 + hstepA, voffA);
            PG8_WAIT_L(8); PG8_BAR; PG8_WAIT_L(0); PG8_MMA(0, 0, At, B0); PG8_BAR; PG8_SCHED;
            PG8_LDB(B1, 1, 1); PG8_STAGE(PG8_SB(1, 0), b3, voffB);
            PG8_BAR; PG8_WAIT_L(0); PG8_MMA(0, 1, At, B1); PG8_BAR;
            PG8_LDA(At, 1, 1); PG8_STAGE(PG8_SA(1, 0), a3, voffA);
            PG8_BAR; PG8_WAIT_L(0); PG8_MMA(1, 0, At, B0); PG8_BAR; PG8_SCHED;
            PG8_STAGE(PG8_SB(1, 1), b3 + hstepB, voffB);
            PG8_WAIT_V(6); PG8_BAR; PG8_MMA(1, 1, At, B1); PG8_BAR;
            }
        }
        if constexpr (ALIGN_EPI) { if (wr == 0) PG8_BAR; }
        if constexpr (!Epi::AFTER_DRAIN) { E(acc, cur, wr, wc, fr, fq); S.done(cur); }
        if (!has_next) break;
#pragma unroll
        for (int a = 0; a < 2; ++a)
#pragma unroll
            for (int b = 0; b < 2; ++b)
#pragma unroll
                for (int m = 0; m < 4; ++m)
#pragma unroll
                    for (int n = 0; n < 2; ++n) acc[a][b][m][n] = (f32x4){0.f, 0.f, 0.f, 0.f};
        cur = nxt; cA = nA; cB = nB; ++ui;
        if constexpr (ALIGN_EPI) { if (wr == 1) PG8_BAR; }
    }
    PG8_WAIT_V(0);
    if constexpr (!ALIGN_EPI) { if (wr == 0) PG8_BAR; }
    PG8_BAR;
    if constexpr (Epi::AFTER_DRAIN) { E.fused(acc, cur, wr, wc, fr, fq, lds, wid, lane); S.done(cur); }
#undef PG8_SA
#undef PG8_SB
#undef PG8_STAGE
#undef PG8_LDA
#undef PG8_LDB
#undef PG8_MMA
#undef PG8_WAIT_V
#undef PG8_WAIT_L
#undef PG8_BAR
#undef PG8_SCHED
}
}

#define LAS __attribute__((address_space(3)))
#define DI __device__ __forceinline__
using pg8::bf16_t; using pg8::bf16x8; using pg8::f32x4; using pg8::u32x4;
typedef short s16x4 __attribute__((ext_vector_type(4)));
typedef short v4i16_t __attribute__((ext_vector_type(4)));
typedef float f32x16 __attribute__((ext_vector_type(16)));
typedef float f32x2_t __attribute__((ext_vector_type(2)));
typedef __bf16 bf16x2_t __attribute__((ext_vector_type(2)));
typedef unsigned u32x2 __attribute__((ext_vector_type(2)));

constexpr int T = 65536, SEQ = 2048, NB = 32, DM = 1024, MEMT = 8192, MEML = 256;
constexpr float EPSN = 1e-6f, LOG2E = 1.4426950408889634f;
constexpr size_t MiB = 1u << 20;
constexpr size_t W_IN = 0, W_UQ = 11 * MiB, W_UKV = 13 * MiB, W_MKV = 14 * MiB, W_OGM = 16 * MiB, W_OMLA = 17 * MiB, W_OMEM = 19 * MiB, W_WOUT = 20 * MiB, W_FF1 = 22 * MiB, W_FF2 = 30 * MiB;
constexpr size_t S_WSP = 39 * MiB + 512 * 1024;
constexpr size_t S_BAR = 39 * MiB;
constexpr size_t S_RSX = 40 * MiB, S_RSM = S_RSX + 256 * 1024, S_SSQCQ = 41 * MiB, S_SSQCKV = 44 * MiB, S_SSQ2 = 46 * MiB, S_ROPE = 50 * MiB;
constexpr size_t A_ZU = 72 * MiB, A_ZV = 136 * MiB, A_X1B = 72 * MiB, A_MEMB = 200 * MiB, A_MEMKV = 216 * MiB, A_Q = 232 * MiB, A_XB = 232 * MiB;
constexpr size_t A_ZCQ = 424 * MiB, A_ZCKV = 488 * MiB, A_ZQM = 520 * MiB, A_ZG = 584 * MiB, A_HDN = 200 * MiB, A_X1 = 712 * MiB, WS_NEED = 968 * MiB;
constexpr int RING_BYTES = 131072, P_OFF = RING_BYTES, LDS_BYTES = 147456;

DI unsigned cvtpk(float lo, float hi) { f32x2_t v = {lo, hi}; bf16x2_t b = __builtin_convertvector(v, bf16x2_t); return __builtin_bit_cast(unsigned, b); }
DI float bflo(unsigned w) { return __uint_as_float(w << 16); }
DI float bfhi(unsigned w) { return __uint_as_float(w & 0xffff0000u); }
DI float wave_sum(float v) {
    v += __builtin_bit_cast(float, __builtin_amdgcn_update_dpp(0, __builtin_bit_cast(int, v), 0x121, 0xf, 0xf, false));
    v += __builtin_bit_cast(float, __builtin_amdgcn_update_dpp(0, __builtin_bit_cast(int, v), 0x122, 0xf, 0xf, false));
    v += __builtin_bit_cast(float, __builtin_amdgcn_update_dpp(0, __builtin_bit_cast(int, v), 0x124, 0xf, 0xf, false));
    v += __builtin_bit_cast(float, __builtin_amdgcn_update_dpp(0, __builtin_bit_cast(int, v), 0x128, 0xf, 0xf, false));
    { const auto r = __builtin_amdgcn_permlane16_swap(__float_as_uint(v), __float_as_uint(v), false, false); v = __uint_as_float(r[0]) + __uint_as_float(r[1]); }
    { const auto r = __builtin_amdgcn_permlane32_swap(__float_as_uint(v), __float_as_uint(v), false, false); v = __uint_as_float(r[0]) + __uint_as_float(r[1]); }
    return v;
}
DI float xsum16(float s) { const auto r = __builtin_amdgcn_permlane16_swap(__float_as_uint(s), __float_as_uint(s), false, false); return __uint_as_float(r[0]) + __uint_as_float(r[1]); }
DI float xsum32(float s) { const auto r = __builtin_amdgcn_permlane32_swap(__float_as_uint(s), __float_as_uint(s), false, false); return __uint_as_float(r[0]) + __uint_as_float(r[1]); }
DI float xmax32(float s) { const auto r = __builtin_amdgcn_permlane32_swap(__float_as_uint(s), __float_as_uint(s), false, false); return fmaxf(__uint_as_float(r[0]), __uint_as_float(r[1])); }
DI float gelu_t(float x) { const float t = x + 0.044715f * x * x * x; return x * __builtin_amdgcn_rcpf(1.0f + __builtin_amdgcn_exp2f(-2.3022082f * t)); }
DI float sigm(float x) { return __builtin_amdgcn_rcpf(1.0f + __builtin_amdgcn_exp2f(-LOG2E * x)); }
DI void st8(bf16_t* p, const float (&v)[8]) { u32x4 w; w.x = cvtpk(v[0], v[1]); w.y = cvtpk(v[2], v[3]); w.z = cvtpk(v[4], v[5]); w.w = cvtpk(v[6], v[7]); *(u32x4*)p = w; }
DI void ld8f(const float* p, float (&v)[8]) { const f32x4 a = *(const f32x4*)p, b = *(const f32x4*)(p + 4); v[0] = a[0]; v[1] = a[1]; v[2] = a[2]; v[3] = a[3]; v[4] = b[0]; v[5] = b[1]; v[6] = b[2]; v[7] = b[3]; }
DI void ld8b(const bf16_t* p, float (&v)[8]) { const u32x4 w = *(const u32x4*)p; v[0] = bflo(w.x); v[1] = bfhi(w.x); v[2] = bflo(w.y); v[3] = bfhi(w.y); v[4] = bflo(w.z); v[5] = bfhi(w.z); v[6] = bflo(w.w); v[7] = bfhi(w.w); }
#define EPI_BAR() do { asm volatile("s_waitcnt lgkmcnt(0)" ::: "memory"); __builtin_amdgcn_s_barrier(); asm volatile("" ::: "memory"); } while (0)

struct Bag {
    const float *x, *g_qn, *g_qp, *g_kn, *g_kp, *g_mq, *g_mk;
    float *rstd_x, *rstd_mem, *ssq_cq, *ssq_ckv, *ssq2; const float* rope;
    bf16_t *zU, *zV, *zCQ, *zCKV, *zQM, *zG, *q, *kv, *memkv, *merged, *x1b, *hdn;
    float *x1, *out;
    LAS float* P;
};
typedef f32x4 AccT[2][2][4][2];
#define ACC8(v, ai, bj, m, s) do { const f32x4 a_ = acc[ai][bj][m][0] * (s), b_ = acc[ai][bj][m][1] * (s); v[0] = a_[0]; v[1] = a_[1]; v[2] = a_[2]; v[3] = a_[3]; v[4] = b_[0]; v[5] = b_[1]; v[6] = b_[2]; v[7] = b_[3]; } while (0)
DI float ssq8(const float (&v)[8]) { float s = (v[0] * v[0] + v[1] * v[1]) + (v[2] * v[2] + v[3] * v[3]) + (v[4] * v[4] + v[5] * v[5]) + (v[6] * v[6] + v[7] * v[7]); s = xsum16(s); s = xsum32(s); return s; }

template <int NS> DI void row_scales(const float* rsp, float inv, int grow0, float (&rs)[8]) {
#pragma unroll
    for (int it = 0; it < 8; ++it) rs[it] = rsp[grow0 + (it >> 2) * 128 + (it & 3) * 16];
    if (NS != 0) {
#pragma unroll
        for (int it = 0; it < 8; ++it) rs[it] = __builtin_amdgcn_rsqf(rs[it] * inv + EPSN); }
}
template <int GS, bool ROPE, int NS>
DI void headnorm(const AccT& acc, const float* rsp, float rs_inv, const float* gain, float oscale, bf16_t* dst, int ld, int grow0, int bj_lo,
                 int wr, int wc, int fr, int fq, LAS float* P, const float* rope) {
    const int rowl0 = wr * 64 + fr, cl0 = wc * 32 + 8 * fq, ch = cl0 & (GS - 1);
#pragma unroll
    for (int ai = 0; ai < 2; ++ai)
#pragma unroll
        for (int m = 0; m < 4; ++m)
#pragma unroll
            for (int bj = 0; bj < 2; ++bj) { if (bj < bj_lo) continue; float v[8]; ACC8(v, ai, bj, m, 1.0f); const float s = ssq8(v);
                if (fq == 0) P[(ai * 128 + m * 16 + rowl0) * 8 + bj * 4 + wc] = s; }
    EPI_BAR();
    float rs[8]; row_scales<NS>(rsp, rs_inv, grow0, rs);
    float g8[8];
    if (ROPE) { const int p0 = ch >> 1;
#pragma unroll
        for (int e = 0; e < 8; ++e) g8[e] = gain[(e & 1) * 32 + p0 + (e >> 1)] * oscale;
    } else { ld8f(gain + ch, g8);
#pragma unroll
        for (int e = 0; e < 8; ++e) g8[e] *= oscale; }
    f32x4 cs[4][2];
#define CS_LOAD(itn) do { const size_t gn_ = (size_t)(grow0 + ((itn) >> 2) * 128 + ((itn) & 3) * 16); cs[(itn) & 3][0] = *(const f32x4*)(rope + gn_ * 64 + ch); cs[(itn) & 3][1] = *(const f32x4*)(rope + gn_ * 64 + ch + 4); } while (0)
    if (ROPE) { CS_LOAD(0); CS_LOAD(1); CS_LOAD(2); CS_LOAD(3); }
#pragma unroll
    for (int it = 0; it < 8; ++it) { const int ai = it >> 2, m = it & 3, rl = ai * 128 + m * 16 + rowl0; const size_t grow = (size_t)(grow0 + ai * 128 + m * 16);
        __builtin_amdgcn_sched_barrier(0);
#pragma unroll
        for (int bj = 0; bj < 2; ++bj) { if (bj < bj_lo) continue;
            const f32x4 p4 = *(const LAS f32x4*)(P + rl * 8 + bj * 4);
            const float tot = ((GS == 128) ? (p4[0] + p4[1]) + (p4[2] + p4[3]) : (wc < 2 ? p4[0] + p4[1] : p4[2] + p4[3])) * rs[it] * rs[it];
            const float r = __builtin_amdgcn_rsqf(tot * (1.0f / GS) + EPSN) * rs[it];
            float v[8]; ACC8(v, ai, bj, m, r);
#pragma unroll
            for (int e = 0; e < 8; ++e) v[e] *= g8[e];
            if (ROPE) { const f32x4 c0 = cs[it & 3][0], c1 = cs[it & 3][1]; const float cv[8] = {c0[0], c0[1], c0[2], c0[3], c1[0], c1[1], c1[2], c1[3]};
#pragma unroll
                for (int k = 0; k < 4; ++k) { const float a = v[2 * k], b = v[2 * k + 1], c = cv[2 * k], sn = cv[2 * k + 1]; v[2 * k] = a * c - b * sn; v[2 * k + 1] = b * c + a * sn; } }
            st8(dst + grow * ld + bj * 128 + cl0, v); }
        __builtin_amdgcn_sched_barrier(0); if (ROPE && it + 4 < 8) CS_LOAD(it + 4); __builtin_amdgcn_sched_barrier(0); }
#undef CS_LOAD
}

enum { K_Z = 0, K_MEMKV, K_Q, K_KV, K_OUT, K_WOUT, K_FF1, K_FF2 };
template <int KIND> struct Epi {
    static constexpr bool PERM = true, AFTER_DRAIN = false;
    Bag b; int br;
    DI void operator()(const AccT& acc, const pg8::Unit& u, int wr, int wc, int fr_in, int fq_in) const {
        int ln_; asm volatile("v_mbcnt_lo_u32_b32 %0, -1, 0\n\tv_mbcnt_hi_u32_b32 %0, -1, %0" : "=v"(ln_));
        const int fr = ln_ & 15, fq = ln_ >> 4; (void)fr_in; (void)fq_in;
        const int grow0 = u.pm * 256 + wr * 64 + fr, cl0 = wc * 32 + 8 * fq, pn = u.pn, tc0 = pn * 256 + cl0;
#define IT_AI (it >> 2)
#define IT_M (it & 3)
#define IT_ROW ((size_t)(grow0 + (it >> 2) * 128 + (it & 3) * 16))
#define ITLOOP _Pragma("unroll") for (int it = 0; it < 8; ++it)
#define BJLOOP _Pragma("unroll") for (int bj = 0; bj < 2; ++bj)
#define SBE() __builtin_amdgcn_sched_barrier(0)
        if (KIND == K_Z) {
            float rs[8]; row_scales<0>(b.rstd_x, 0.f, grow0, rs);
            if (pn < 4) { bf16_t* dst = (pn < 2 ? b.zU : b.zV) + (pn & 1) * 256 + cl0;
                ITLOOP { BJLOOP { float v[8]; ACC8(v, IT_AI, bj, IT_M, rs[it]);
#pragma unroll
                    for (int e = 0; e < 8; ++e) v[e] = gelu_t(v[e]);
                    st8(dst + IT_ROW * 512 + bj * 128, v); } SBE(); }
            } else if (pn == 4 || pn == 6) { bf16_t* dst = (pn == 4 ? b.zCQ : b.zCKV) + cl0; const int ld = (pn == 4) ? 512 : 256; float* sq = (pn == 4) ? b.ssq_cq : b.ssq_ckv;
                ITLOOP { float s = 0.f; BJLOOP { float v[8]; ACC8(v, IT_AI, bj, IT_M, rs[it]); s += ssq8(v); st8(dst + IT_ROW * ld + bj * 128, v); } if (fq == 0) __hip_atomic_fetch_add(sq + IT_ROW, s, __ATOMIC_RELAXED, __HIP_MEMORY_SCOPE_AGENT); SBE(); }
            } else if (pn == 5) {
                ITLOOP { float v[8]; ACC8(v, IT_AI, 0, IT_M, rs[it]); const float s = ssq8(v); st8(b.zCQ + IT_ROW * 512 + 256 + cl0, v); if (fq == 0) __hip_atomic_fetch_add(b.ssq_cq + IT_ROW, s, __ATOMIC_RELAXED, __HIP_MEMORY_SCOPE_AGENT); SBE(); }
                headnorm<64, true, 0>(acc, b.rstd_x, 0.f, b.g_kp, 1.0f, b.zCQ + 256, 512, grow0, 1, wr, wc, fr, fq, b.P, b.rope);
            } else if (pn < 9) {
                headnorm<128, false, 0>(acc, b.rstd_x, 0.f, b.g_mq, LOG2E * 0.08838834764831845f, b.zQM + (pn - 7) * 256, 512, grow0, 0, wr, wc, fr, fq, b.P, nullptr);
            } else { bf16_t* dst = b.zG + (pn - 9) * 256 + cl0;
                ITLOOP { BJLOOP { float v[8]; ACC8(v, IT_AI, bj, IT_M, rs[it]);
#pragma unroll
                    for (int e = 0; e < 8; ++e) v[e] = sigm(v[e]);
                    st8(dst + IT_ROW * 3072 + bj * 128, v); } SBE(); }
            }
        }
        if (KIND == K_MEMKV) {
            if (pn < 2) headnorm<128, false, 0>(acc, b.rstd_mem, 0.f, b.g_mk, 1.0f, b.memkv + pn * 256, 1024, grow0, 0, wr, wc, fr, fq, b.P, nullptr);
            else { float rs[8]; row_scales<0>(b.rstd_mem, 0.f, grow0, rs); ITLOOP { BJLOOP { float v[8]; ACC8(v, IT_AI, bj, IT_M, rs[it]); st8(b.memkv + IT_ROW * 1024 + tc0 + bj * 128, v); } SBE(); } }
        }
        if (KIND == K_Q) {
            const float qs = LOG2E * 0.07216878364870323f;
            if (pn < 4) headnorm<128, false, 1>(acc, b.ssq_cq, 1.0f / 384.0f, b.g_qn, qs, b.q + pn * 256, 1536, grow0, 0, wr, wc, fr, fq, b.P, nullptr);
            else headnorm<64, true, 1>(acc, b.ssq_cq, 1.0f / 384.0f, b.g_qp, qs, b.q + pn * 256, 1536, grow0, 0, wr, wc, fr, fq, b.P, b.rope);
        }
        if (KIND == K_KV) {
            if (pn < 4) headnorm<128, false, 1>(acc, b.ssq_ckv, 1.0f / 256.0f, b.g_kn, 1.0f, b.kv + pn * 256, 2048, grow0, 0, wr, wc, fr, fq, b.P, nullptr);
            else { float rs[8]; row_scales<1>(b.ssq_ckv, 1.0f / 256.0f, grow0, rs); ITLOOP { BJLOOP { float v[8]; ACC8(v, IT_AI, bj, IT_M, rs[it]); st8(b.kv + IT_ROW * 2048 + tc0 + bj * 128, v); } SBE(); } }
        }
        if (KIND == K_OUT) {
            const int brn = br & 3; const bool accum = (br >> 8) != 0;
            u32x4 pg[4][2], pm[4][2];
#define OUT_LOAD(itn, buf) do { const size_t rw_ = (size_t)(grow0 + ((itn) >> 2) * 128 + ((itn) & 3) * 16); BJLOOP { pg[buf][bj] = *(const u32x4*)(b.zG + rw_ * 3072 + brn * 1024 + tc0 + bj * 128); \
                if (accum) pm[buf][bj] = *(const u32x4*)(b.merged + rw_ * 1024 + tc0 + bj * 128); } } while (0)
            OUT_LOAD(0, 0); OUT_LOAD(1, 1); OUT_LOAD(2, 2); OUT_LOAD(3, 3); SBE();
            ITLOOP {
                BJLOOP { const u32x4 gw = pg[it & 3][bj]; const float g[8] = {bflo(gw.x), bfhi(gw.x), bflo(gw.y), bfhi(gw.y), bflo(gw.z), bfhi(gw.z), bflo(gw.w), bfhi(gw.w)};
                    float v[8]; ACC8(v, IT_AI, bj, IT_M, 1.0f);
                    if (accum) { const u32x4 ow = pm[it & 3][bj]; const float o[8] = {bflo(ow.x), bfhi(ow.x), bflo(ow.y), bfhi(ow.y), bflo(ow.z), bfhi(ow.z), bflo(ow.w), bfhi(ow.w)};
#pragma unroll
                        for (int e = 0; e < 8; ++e) v[e] = o[e] + g[e] * v[e];
                    } else {
#pragma unroll
                        for (int e = 0; e < 8; ++e) v[e] = g[e] * v[e]; }
                    st8(b.merged + IT_ROW * 1024 + tc0 + bj * 128, v); }
                SBE(); if (it + 4 < 8) OUT_LOAD(it + 4, it & 3); SBE(); }
#undef OUT_LOAD
        }
        if (KIND == K_WOUT) {
            f32x4 px[4][2][2];
#define RES_LOAD(itn, buf) do { const float* p_ = b.x + (size_t)(grow0 + ((itn) >> 2) * 128 + ((itn) & 3) * 16) * 1024 + tc0; BJLOOP { px[buf][bj][0] = *(const f32x4*)(p_ + bj * 128); px[buf][bj][1] = *(const f32x4*)(p_ + bj * 128 + 4); } } while (0)
            RES_LOAD(0, 0); RES_LOAD(1, 1); RES_LOAD(2, 2); RES_LOAD(3, 3); SBE();
            ITLOOP {
                float s = 0.f;
                BJLOOP { float v[8]; ACC8(v, IT_AI, bj, IT_M, 1.0f); const f32x4 x0 = px[it & 3][bj][0], x1v = px[it & 3][bj][1];
                    v[0] += x0[0]; v[1] += x0[1]; v[2] += x0[2]; v[3] += x0[3]; v[4] += x1v[0]; v[5] += x1v[1]; v[6] += x1v[2]; v[7] += x1v[3];
#pragma unroll
                    for (int e = 0; e < 8; ++e) s += v[e] * v[e];
                    st8(b.x1b + IT_ROW * 1024 + tc0 + bj * 128, v); }
                s = xsum16(s); s = xsum32(s); if (fq == 0) __hip_atomic_fetch_add(b.ssq2 + IT_ROW, s, __ATOMIC_RELAXED, __HIP_MEMORY_SCOPE_AGENT);
                SBE(); if (it + 4 < 8) RES_LOAD(it + 4, it & 3); SBE(); }
#undef RES_LOAD
        }
        if (KIND == K_FF2) {
            u32x4 px[4][2];
#define RES_LOAD(itn, buf) do { const bf16_t* p_ = b.x1b + (size_t)(grow0 + ((itn) >> 2) * 128 + ((itn) & 3) * 16) * 1024 + tc0; BJLOOP { px[buf][bj] = *(const u32x4*)(p_ + bj * 128); } } while (0)
            RES_LOAD(0, 0); RES_LOAD(1, 1); RES_LOAD(2, 2); RES_LOAD(3, 3); SBE();
            ITLOOP {
                BJLOOP { float v[8]; ACC8(v, IT_AI, bj, IT_M, 1.0f); const u32x4 w = px[it & 3][bj];
                    float* op = b.out + IT_ROW * 1024 + tc0 + bj * 128;
                    *(f32x4*)op = (f32x4){v[0] + bflo(w.x), v[1] + bfhi(w.x), v[2] + bflo(w.y), v[3] + bfhi(w.y)}; *(f32x4*)(op + 4) = (f32x4){v[4] + bflo(w.z), v[5] + bfhi(w.z), v[6] + bflo(w.w), v[7] + bfhi(w.w)}; }
                SBE(); if (it + 4 < 8) RES_LOAD(it + 4, it & 3); SBE(); }
#undef RES_LOAD
        }
        if (KIND == K_FF1) {
            float rs[8]; row_scales<1>(b.ssq2, 1.0f / 1024.0f, grow0, rs);
            ITLOOP { BJLOOP { float v[8]; ACC8(v, IT_AI, bj, IT_M, rs[it]);
#pragma unroll
                for (int e = 0; e < 8; ++e) { const float t = fmaxf(v[e], 0.f); v[e] = t * t; }
                st8(b.hdn + IT_ROW * 4096 + tc0 + bj * 128, v); } SBE(); }
        }
#undef IT_AI
#undef IT_M
#undef IT_ROW
#undef ITLOOP
#undef BJLOOP
#undef SBE
    }
};

DI int crow(int r, int hi) { return (r & 3) + 8 * (r >> 2) + 4 * hi; }
DI s16x4 vtr(const LAS char* p) { return __builtin_bit_cast(s16x4, __builtin_amdgcn_ds_read_tr16_b64_v4i16((LAS v4i16_t*)p)); }
#define MFMA32(a, b, c) __builtin_amdgcn_mfma_f32_32x32x16_bf16((a), (b), (c), 0, 0, 0)
DI bf16x8 pack8(const f32x16& x, int o) { u32x4 w; w.x = cvtpk(x[o], x[o + 1]); w.y = cvtpk(x[o + 2], x[o + 3]); w.z = cvtpk(x[o + 4], x[o + 5]); w.w = cvtpk(x[o + 6], x[o + 7]); return __builtin_bit_cast(bf16x8, w); }

template <int DQK, bool CAUSAL, int ABL = 0>
DI void attn_unit(LAS char* lds, const bf16_t* Qa, int pQa, const bf16_t* Qb, int pQb, const bf16_t* Ka, int pKa, const bf16_t* Kb, int pKb,
                  const bf16_t* V, int pV, bf16_t* O, int pO, int q0, int NT) {
    constexpr int KP = DQK * 2 + 16, VP = 320, KBUF = 64 * KP, VBUF = 64 * VP, SLOT = KBUF + VBUF, NDS = DQK / 16, KB = (DQK == 192) ? 3 : 4, NKB = NDS / KB;
    constexpr int KC16 = KP / 16, NKC = KBUF / 1024, NVC = VBUF / 1024, NCH = NKC + NVC, NOPS = (NCH + 7) / 8;
    static_assert(KBUF % 1024 == 0 && VBUF % 1024 == 0 && 3 * SLOT <= P_OFF + 8192 && (NOPS == 5 || NOPS == 6), "attention ring geometry");
    int tid_ = threadIdx.x; asm volatile("" : "+v"(tid_));
    const int tid = tid_, lane = tid & 63, wid = __builtin_amdgcn_readfirstlane(tid >> 6), r = lane & 31, h = lane >> 5;
    const size_t qrow = (size_t)(q0 + 32 * wid + r);
    asm volatile("s_waitcnt lgkmcnt(0)\n\ts_barrier" ::: "memory");
    const char* gp[NOPS]; unsigned ginc[NOPS]; int loff[NOPS];
#pragma unroll
    for (int j = 0; j < NOPS; ++j) { const int c = (wid + 8 * j < NCH) ? wid + 8 * j : NCH - 1; loff[j] = c * 1024;
        if (c < NKC) { const int idx = 64 * c + lane, row = idx / KC16, cb = idx - row * KC16;
            if (DQK == 192 && cb >= 16 && cb < 24) { gp[j] = (const char*)(Kb + (size_t)row * pKb + (cb - 16) * 8); ginc[j] = 64u * (unsigned)pKb * 2u; }
            else { gp[j] = (const char*)(Ka + (size_t)row * pKa + (cb < 16 ? cb * 8 : 0)); ginc[j] = 64u * (unsigned)pKa * 2u; }
        } else { const int idx = 64 * (c - NKC) + lane, row = idx / 20, cb = idx - row * 20;
            gp[j] = (const char*)(V + (size_t)row * pV + (cb < 16 ? cb * 8 : 0)); ginc[j] = 64u * (unsigned)pV * 2u; } }
#define AT_ISSUE(slot) do { if (ABL & 8) break; _Pragma("unroll") for (int j = 0; j < NOPS; ++j) { \
        __builtin_amdgcn_global_load_lds((const unsigned*)gp[j], (LAS unsigned*)(lds + (slot) * SLOT + loff[j]), 16, 0, 0); gp[j] += ginc[j]; } } while (0)
#define AT_WAITBAR(n) asm volatile("s_waitcnt vmcnt(" #n ") lgkmcnt(0)\n\ts_barrier" ::: "memory")
#define AT_WAIT_NEWEST() do { if (NOPS == 6) AT_WAITBAR(6); else AT_WAITBAR(5); } while (0)
#define SB() __builtin_amdgcn_sched_barrier(0)
#define LDK(dst, bi) do { _Pragma("unroll") for (int j = 0; j < KB; ++j) { dst[2 * j] = *(const LAS bf16x8*)(kb_ + ((bi) * KB + j) * 32); dst[2 * j + 1] = *(const LAS bf16x8*)(kb_ + 32 * KP + ((bi) * KB + j) * 32); } } while (0)
#define MMK(src, bi) do { if (ABL & 1) { _Pragma("unroll") for (int j = 0; j < KB; ++j) { s0[j] += (float)src[2 * j][0]; s1[j] += (float)src[2 * j + 1][0]; } break; } _Pragma("unroll") for (int j = 0; j < KB; ++j) { s0 = MFMA32(src[2 * j], qf[(bi) * KB + j], s0); s1 = MFMA32(src[2 * j + 1], qf[(bi) * KB + j], s1); } } while (0)
#define TRR(dst, off) asm volatile("ds_read_b64_tr_b16 %0, %1 offset:%c2" : "=&v"(dst) : "v"(va_), "i"(off) : "memory")
#define LDV(lo, hi, s) do { _Pragma("unroll") for (int d = 0; d < 4; ++d) { TRR(lo[d], (16 * (s)) * VP + d * 64); TRR(hi[d], (16 * (s) + 8) * VP + d * 64); } } while (0)
#define MMV(lo, hi, s) do { if (ABL & 4) { _Pragma("unroll") for (int d = 0; d < 4; ++d) o[d][0] += (float)lo[d][0] + (float)hi[d][0] + (float)pf[s][d]; break; } _Pragma("unroll") for (int d = 0; d < 4; ++d) o[d] = MFMA32(((bf16x8){lo[d][0], lo[d][1], lo[d][2], lo[d][3], hi[d][0], hi[d][1], hi[d][2], hi[d][3]}), pf[s], o[d]); } while (0)
#define LGKM(n) asm volatile("s_waitcnt lgkmcnt(" #n ")" ::: "memory")
    AT_ISSUE(0);
    if (NT > 1) AT_ISSUE(1);
    bf16x8 qf[NDS];
#pragma unroll
    for (int ds = 0; ds < 8; ++ds) qf[ds] = *(const bf16x8*)(Qa + qrow * pQa + 16 * ds + 8 * h);
    if (DQK == 192) {
#pragma unroll
        for (int ds = 8; ds < NDS; ++ds) qf[ds] = *(const bf16x8*)(Qb + qrow * pQb + 16 * (ds - 8) + 8 * h); }
    AT_WAITBAR(0);
    float mrow = -INFINITY, lsum = 0.f;
    f32x16 o[4];
#pragma unroll
    for (int d = 0; d < 4; ++d)
#pragma unroll
        for (int i = 0; i < 16; ++i) o[d][i] = 0.f;
    const int qmin = q0 + 32 * wid, qpos = qmin + r;
    const int q4 = (lane & 15) >> 2, p4 = lane & 3, blk = (lane >> 4) & 1;
    int sc = 0, sn2 = 2;
#pragma unroll 1
    for (int t = 0; t < NT; ++t) {
        if (t + 2 < NT) AT_ISSUE(sn2);
        const bool active = !CAUSAL || (64 * t <= qmin + 31);
        if (active) {
            const LAS char* kb_ = lds + sc * SLOT + r * KP + 16 * h; const LAS char* vb_ = lds + sc * SLOT + KBUF + (4 * h + q4) * VP + blk * 32 + p4 * 8;
            f32x16 s0, s1;
#pragma unroll
            for (int i = 0; i < 16; ++i) { s0[i] = 0.f; s1[i] = 0.f; }
            bf16x8 fa[2 * KB], fb[2 * KB];
            SB(); LDK(fa, 0); SB();
#pragma unroll
            for (int bi = 0; bi < NKB; ++bi) {
                if (bi & 1) { if (bi + 1 < NKB) LDK(fa, bi + 1); SB(); MMK(fb, bi); SB(); }
                else { if (bi + 1 < NKB) LDK(fb, bi + 1); SB(); MMK(fa, bi); SB(); } }
            if (CAUSAL && (64 * t + 63 > qmin)) {
#pragma unroll
                for (int i = 0; i < 16; ++i) { const int kv = 64 * t + crow(i, h); if (kv > qpos) s0[i] = -INFINITY; if (kv + 32 > qpos) s1[i] = -INFINITY; } }
            float a_ = fmaxf(fmaxf(s0[0], s0[1]), s1[0]), b_ = fmaxf(fmaxf(s0[2], s0[3]), s1[1]); a_ = fmaxf(fmaxf(a_, s1[2]), s1[3]);
#pragma unroll
            for (int i = 4; i < 16; i += 4) { a_ = fmaxf(fmaxf(a_, s0[i]), s0[i + 1]); b_ = fmaxf(fmaxf(b_, s0[i + 2]), s0[i + 3]); a_ = fmaxf(fmaxf(a_, s1[i]), s1[i + 1]); b_ = fmaxf(fmaxf(b_, s1[i + 2]), s1[i + 3]); }
            const float mx = xmax32(fmaxf(a_, b_));
            const float mn = fmaxf(mrow, mx), alpha = __builtin_amdgcn_exp2f(mrow - mn); mrow = mn;
            const unsigned va_ = (unsigned)(size_t)vb_;
            s16x4 la[4], ha[4], lb[4], hb[4];
            SB(); LDV(la, ha, 0); SB();
            float ps = 0.f;
#pragma unroll
            for (int i = 0; i < 16; ++i) { if (!(ABL & 2)) { s0[i] = __builtin_amdgcn_exp2f(s0[i] - mn); s1[i] = __builtin_amdgcn_exp2f(s1[i] - mn); } ps += s0[i] + s1[i]; }
            lsum = lsum * alpha + ps;
            if (__any(alpha != 1.0f)) {
#pragma unroll
                for (int d = 0; d < 4; ++d)
#pragma unroll
                    for (int i = 0; i < 16; ++i) o[d][i] *= alpha; }
            bf16x8 pf[4]; pf[0] = pack8(s0, 0); pf[1] = pack8(s0, 8); pf[2] = pack8(s1, 0); pf[3] = pack8(s1, 8);
            SB(); LDV(lb, hb, 1); LGKM(8); SB(); MMV(la, ha, 0); SB();
            LDV(la, ha, 2); LGKM(8); SB(); MMV(lb, hb, 1); SB();
            LDV(lb, hb, 3); LGKM(8); SB(); MMV(la, ha, 2); SB();
            LGKM(0); SB(); MMV(lb, hb, 3); SB();
        }
        if (t + 1 < NT) { if (t + 2 < NT) AT_WAIT_NEWEST(); else AT_WAITBAR(0); }
        sn2 = sc; sc = (sc == 2) ? 0 : sc + 1;
    }
    lsum = xsum32(lsum);
    const float inv = 1.0f / lsum;
    bf16_t* orow = O + qrow * pO + 4 * h;
#pragma unroll
    for (int d = 0; d < 4; ++d)
#pragma unroll
        for (int g = 0; g < 4; ++g) { u32x2 w; w.x = cvtpk(o[d][4 * g] * inv, o[d][4 * g + 1] * inv); w.y = cvtpk(o[d][4 * g + 2] * inv, o[d][4 * g + 3] * inv); *(u32x2*)(orow + 32 * d + 8 * g) = w; }
#undef AT_ISSUE
#undef AT_WAITBAR
#undef AT_WAIT_NEWEST
#undef SB
#undef LDK
#undef MMK
#undef LDV
#undef MMV
#undef TRR
#undef LGKM
}

DI void gmlp_unit(LAS char* lds, bf16_t* zU, const bf16_t* zV, const float* g_ln, const float* b_ln, const bf16_t* Wb, const float* b_sp, int R0, bool dummy = false) {
    constexpr int WP = 272, VP = 320;
    int tid_ = threadIdx.x; asm volatile("" : "+v"(tid_));
    const int tid = tid_, lane = tid & 63, wid = __builtin_amdgcn_readfirstlane(tid >> 6), r = lane & 31, h = lane >> 5;
    LAS char* Wl = lds; LAS char* Vn = lds + 128 * WP; LAS float* St = (LAS float*)(lds + 128 * WP + 128 * VP);
    __syncthreads();
    { u32x4 rw[16];
#pragma unroll
      for (int i = 0; i < 16; ++i) rw[i] = *(const u32x4*)(zV + (size_t)(R0 + wid * 16 + i) * 512 + lane * 8);
#pragma unroll
      for (int i = 0; i < 16; ++i) { const int s = wid * 16 + i; const u32x4 w = rw[i];
        const float v[8] = {bflo(w.x), bfhi(w.x), bflo(w.y), bfhi(w.y), bflo(w.z), bfhi(w.z), bflo(w.w), bfhi(w.w)};
        float a = 0.f, q = 0.f;
#pragma unroll
        for (int e = 0; e < 8; ++e) { a += v[e]; q += v[e] * v[e]; }
        a = wave_sum(a); q = wave_sum(q);
        const float mu = a * (1.0f / 512.0f), var = fmaxf(q * (1.0f / 512.0f) - mu * mu, 0.f);
        if (lane == 0) { St[2 * s] = mu; St[2 * s + 1] = __builtin_amdgcn_rsqf(var + EPSN); } } }
    const int q4 = (lane & 15) >> 2, p4 = lane & 3, blk = (lane >> 4) & 1, cb = wid & 3, tp = wid >> 2;
    const int lt = tid >> 4, lc8 = (tid & 15) * 8;
    u32x4 pw[4], pv[4]; f32x4 pg[2], pb[2];
#define GM_FETCH(g) do { _Pragma("unroll") for (int i = 0; i < 4; ++i) { pw[i] = *(const u32x4*)(Wb + (size_t)(g) * 16384 + (lt + 32 * i) * 128 + lc8); pv[i] = *(const u32x4*)(zV + (size_t)(R0 + lt + 32 * i) * 512 + (g) * 128 + lc8); } \
        pg[0] = *(const f32x4*)(g_ln + (g) * 128 + lc8); pg[1] = *(const f32x4*)(g_ln + (g) * 128 + lc8 + 4); pb[0] = *(const f32x4*)(b_ln + (g) * 128 + lc8); pb[1] = *(const f32x4*)(b_ln + (g) * 128 + lc8 + 4); } while (0)
    GM_FETCH(0);
#pragma unroll 1
    for (int g = 0; g < 4; ++g) {
        __syncthreads();
#pragma unroll
        for (int i = 0; i < 4; ++i) { const int s = lt + 32 * i;
            *(LAS u32x4*)(Wl + s * WP + lc8 * 2) = pw[i];
            const u32x4 w = pv[i]; float v[8] = {bflo(w.x), bfhi(w.x), bflo(w.y), bfhi(w.y), bflo(w.z), bfhi(w.z), bflo(w.w), bfhi(w.w)};
            const float mu = St[2 * s], rsd = St[2 * s + 1];
#pragma unroll
            for (int e = 0; e < 8; ++e) v[e] = (v[e] - mu) * rsd * pg[e >> 2][e & 3] + pb[e >> 2][e & 3];
            u32x4 o; o.x = cvtpk(v[0], v[1]); o.y = cvtpk(v[2], v[3]); o.z = cvtpk(v[4], v[5]); o.w = cvtpk(v[6], v[7]); *(LAS u32x4*)(Vn + s * VP + lc8 * 2) = o; }
        __syncthreads();
        if (g + 1 < 4) GM_FETCH(g + 1);
        u32x2 uw[2][4]; float bs[2];
#pragma unroll
        for (int tb = 0; tb < 2; ++tb) { const int t = 32 * (2 * tp + tb) + r; bs[tb] = b_sp[g * 128 + t]; const bf16_t* up = zU + (size_t)(R0 + t) * 512 + g * 128 + 32 * cb + 4 * h;
#pragma unroll
            for (int k = 0; k < 4; ++k) uw[tb][k] = *(const u32x2*)(up + 8 * k); }
        f32x16 a0, a1;
#pragma unroll
        for (int i = 0; i < 16; ++i) { a0[i] = 0.f; a1[i] = 0.f; }
        const int tb0 = 2 * tp, tb1 = 2 * tp + 1;
        const LAS char* vb_ = Vn + (8 * h + q4) * VP + cb * 64 + blk * 32 + p4 * 8;
        bf16x8 af[8], b0f[8], b1f[8];
#pragma unroll
        for (int ss = 0; ss < 8; ++ss) {
            if (16 * ss <= 32 * tb1 + 31) {
                const s16x4 lo = vtr(vb_ + (16 * ss) * VP), hi = vtr(vb_ + (16 * ss + 4) * VP);
                af[ss] = (bf16x8){lo[0], lo[1], lo[2], lo[3], hi[0], hi[1], hi[2], hi[3]};
                b1f[ss] = *(const LAS bf16x8*)(Wl + (32 * tb1 + r) * WP + (16 * ss + 8 * h) * 2);
                if (16 * ss <= 32 * tb0 + 31) b0f[ss] = *(const LAS bf16x8*)(Wl + (32 * tb0 + r) * WP + (16 * ss + 8 * h) * 2); } }
        __builtin_amdgcn_sched_barrier(0);
#pragma unroll
        for (int ss = 0; ss < 8; ++ss) {
            if (16 * ss <= 32 * tb1 + 31) { a1 = MFMA32(af[ss], b1f[ss], a1); if (16 * ss <= 32 * tb0 + 31) a0 = MFMA32(af[ss], b0f[ss], a0); } }
#pragma unroll
        for (int tb = 0; tb < 2; ++tb) { const int t = 32 * (2 * tp + tb) + r; bf16_t* up = zU + (size_t)(R0 + t) * 512 + g * 128 + 32 * cb + 4 * h;
#pragma unroll
            for (int k = 0; k < 4; ++k) { const u32x2 u2 = uw[tb][k]; u32x2 w; const f32x16& a = tb ? a1 : a0; const float b_ = bs[tb];
                w.x = cvtpk(bflo(u2.x) * (a[4 * k] + b_), bfhi(u2.x) * (a[4 * k + 1] + b_)); w.y = cvtpk(bflo(u2.y) * (a[4 * k + 2] + b_), bfhi(u2.y) * (a[4 * k + 3] + b_));
                if (dummy) w = u2;
                *(u32x2*)(up + 8 * k) = w; } }
    }
#undef GM_FETCH
}

DI int srccol(int mat, int n) {
    if (mat == 0) { if (n < 1408) return n; if (n < 1472) { const int c = n - 1408; return 1664 + (c & 1) * 32 + (c >> 1); } if (n < 1536) return -1; if (n < 1792) return 1408 + (n - 1536); return n - 64; }
    if (mat == 1) { if (n < 1024) return (n >> 7) * 192 + (n & 127); const int c = n - 1024, hh = c >> 6, cc = c & 63; return hh * 192 + 128 + (cc & 1) * 32 + (cc >> 1); }
    if (mat == 2) { if (n < 1024) return (n >> 7) * 256 + (n & 127); const int c = n - 1024; return (c >> 7) * 256 + 128 + (c & 127); }
    return n;
}
DI void transpose_item(const float* W, const float* gain, int K, int Ns, int Nd, int mat, bf16_t* WT, LAS float* scr, int item, int lane) {
    const int nblk = Nd / 32, kb = item / nblk, nb = item % nblk, k0 = 64 * kb, n0 = 32 * nb;
    const int sc = srccol(mat, n0 + (lane & 31));
#pragma unroll 8
    for (int i = 0; i < 32; ++i) { const int kk = 2 * i + (lane >> 5); float v = 0.f; if (sc >= 0) v = W[(size_t)(k0 + kk) * Ns + sc]; if (gain) v *= gain[k0 + kk]; scr[kk * 33 + (lane & 31)] = v; }
    asm volatile("s_waitcnt lgkmcnt(0)" ::: "memory");
    const int c = lane & 7;
#pragma unroll
    for (int j = 0; j < 4; ++j) { const int n = (lane >> 3) + 8 * j; const LAS float* s = scr + (8 * c) * 33 + n;
        u32x4 o; o.x = cvtpk(s[0 * 33], s[1 * 33]); o.y = cvtpk(s[2 * 33], s[3 * 33]); o.z = cvtpk(s[4 * 33], s[5 * 33]); o.w = cvtpk(s[6 * 33], s[7 * 33]);
        *(u32x4*)(WT + (size_t)(n0 + n) * K + k0 + 8 * c) = o; }
    asm volatile("s_waitcnt lgkmcnt(0)" ::: "memory");
}
template <int NR> DI void rows_to_bf16(const float* x0, bf16_t* o0, float* rstd0, int rstride, int nvalid, int lane) {
    f32x4 v[NR][4];
#pragma unroll
    for (int r = 0; r < NR; ++r) { const f32x4* xr = (const f32x4*)(x0 + (size_t)(r < nvalid ? r : 0) * rstride * 1024) + lane;
#pragma unroll
        for (int j = 0; j < 4; ++j) v[r][j] = xr[64 * j]; }
#pragma unroll
    for (int r = 0; r < NR; ++r) { if (r >= nvalid) break; float s = 0.f;
#pragma unroll
        for (int j = 0; j < 4; ++j) s += (v[r][j][0] * v[r][j][0] + v[r][j][1] * v[r][j][1]) + (v[r][j][2] * v[r][j][2] + v[r][j][3] * v[r][j][3]);
        s = wave_sum(s);
        u32x2* o8 = (u32x2*)(o0 + (size_t)r * rstride * 1024) + lane;
#pragma unroll
        for (int j = 0; j < 4; ++j) { u32x2 w; w.x = cvtpk(v[r][j][0], v[r][j][1]); w.y = cvtpk(v[r][j][2], v[r][j][3]); o8[64 * j] = w; }
        if (lane == 0) rstd0[(size_t)r * rstride] = __builtin_amdgcn_rsqf(s * (1.0f / 1024.0f) + EPSN); }
}


#define RLX_AGENT __ATOMIC_RELAXED, __HIP_MEMORY_SCOPE_AGENT
#define XB_TMO      128
#define XB_XCNT(j)  (256  + 64 * (j))
#define XB_XSUB(j)  (1280 + 64 * (j))
#define XB_XGEN(j)  (2304 + 64 * (j))
#define XB_TOP      3328
#define XB_TOPGEN   3392
#define XCD_BAR_WORDS 3456
#define XB_SPIN_CAP (1u << 18)

__device__ __forceinline__ unsigned xb_ld(unsigned* p)              { return __hip_atomic_load(p, __ATOMIC_RELAXED, __HIP_MEMORY_SCOPE_AGENT); }
__device__ __forceinline__ unsigned xb_add(unsigned* p, unsigned v) { return __hip_atomic_fetch_add(p, v, __ATOMIC_RELAXED, __HIP_MEMORY_SCOPE_AGENT); }
__device__ __forceinline__ unsigned xb_xcc_id() { return (unsigned)__builtin_amdgcn_s_getreg((3 << 11) | 20) & 0xFu; }
#define XB_SPIN(cond, bar) do { unsigned _sp = 0; while (cond) { __builtin_amdgcn_s_sleep(1); \
    if ((++_sp & 255u) == 0u) { if (xb_ld(&(bar)[XB_TMO])) break; if (_sp > XB_SPIN_CAP) { atomicAdd(&(bar)[XB_TMO], 1u); break; } } } } while (0)

struct XcdBarrier {
    unsigned* bar; unsigned x;
    volatile LAS unsigned* st;
};

__device__ __forceinline__ XcdBarrier xcd_barrier_post(unsigned* bar, volatile LAS unsigned* st) {
    XcdBarrier b; b.bar = bar; b.x = xb_xcc_id(); b.st = st;
    if (threadIdx.x == 0) (void)xb_add(&bar[XB_XCNT(b.x)], 1u);
    return b;
}
__device__ __forceinline__ void xcd_barrier_complete(unsigned* bar, unsigned x, unsigned& nloc, unsigned& nx) {
    const unsigned G = gridDim.x * gridDim.y * gridDim.z;
    unsigned sum, cnt, mine, sp = 0u;
    for (;;) {
        sum = 0u; cnt = 0u; mine = 0u;
#pragma unroll
        for (unsigned j = 0; j < 16; ++j) { const unsigned c = xb_ld(&bar[XB_XCNT(j)]); sum += c; cnt += (c > 0u) ? 1u : 0u; mine = (j == x) ? c : mine; }
        if (sum == G) break;
        __builtin_amdgcn_s_sleep(1);
        if ((++sp & 255u) == 0u) { if (xb_ld(&bar[XB_TMO])) break; if (sp > XB_SPIN_CAP) { atomicAdd(&bar[XB_TMO], 1u); break; } }
    }
    nloc = mine > 0u ? mine : 1u; nx = cnt > 0u ? cnt : 1u;
}

__device__ __forceinline__ void xcd_barrier(const XcdBarrier& b) {
    asm volatile("s_waitcnt vmcnt(0)" ::: "memory");
    __syncthreads();
    if (threadIdx.x == 0) {
        unsigned* bar = b.bar;
        __builtin_amdgcn_s_waitcnt(0);
        unsigned nloc = b.st[0], nx = b.st[1];
        if (nloc == 0u) { xcd_barrier_complete(bar, b.x, nloc, nx); b.st[0] = nloc; b.st[1] = nx; }
        const unsigned old = xb_add(&bar[XB_XSUB(b.x)], 1u);
        const unsigned gen = old / nloc;
        if (old + 1u == (gen + 1u) * nloc) {
            __builtin_amdgcn_fence(__ATOMIC_RELEASE, "agent");
            asm volatile("s_waitcnt vmcnt(0)" ::: "memory");
            const unsigned og = xb_add(&bar[XB_TOP], 1u);
            const unsigned tg = og / nx;
            if (og + 1u == (tg + 1u) * nx) xb_add(&bar[XB_TOPGEN], 1u);
            else XB_SPIN(xb_ld(&bar[XB_TOPGEN]) == tg, bar);
            __builtin_amdgcn_fence(__ATOMIC_ACQUIRE, "agent");
            xb_add(&bar[XB_XGEN(b.x)], 1u);
            asm volatile("s_waitcnt vmcnt(0)" ::: "memory");
        } else {
            XB_SPIN(xb_ld(&bar[XB_XGEN(b.x)]) == gen, bar);
            __builtin_amdgcn_fence(__ATOMIC_ACQUIRE, "agent");
            asm volatile("s_waitcnt vmcnt(0)" ::: "memory");
        }
    }
    __syncthreads();
}

struct Args { const float* in[28]; float* out; unsigned char* ws; };

typedef const __attribute__((address_space(4))) Args* KArgP;
DI Bag make_bag(KArgP kp, LAS unsigned char* lds) {
    unsigned char* ws = kp->ws; Bag b;
    b.x = kp->in[0]; b.g_qn = kp->in[9]; b.g_qp = kp->in[10]; b.g_kn = kp->in[11]; b.g_kp = kp->in[12]; b.g_mq = kp->in[19]; b.g_mk = kp->in[20];
    b.rstd_x = (float*)(ws + S_RSX); b.rstd_mem = (float*)(ws + S_RSM); b.ssq_cq = (float*)(ws + S_SSQCQ); b.ssq_ckv = (float*)(ws + S_SSQCKV); b.ssq2 = (float*)(ws + S_SSQ2); b.rope = (const float*)(ws + S_ROPE);
    b.zU = (bf16_t*)(ws + A_ZU); b.zV = (bf16_t*)(ws + A_ZV); b.zCQ = (bf16_t*)(ws + A_ZCQ); b.zCKV = (bf16_t*)(ws + A_ZCKV); b.zQM = (bf16_t*)(ws + A_ZQM); b.zG = (bf16_t*)(ws + A_ZG);
    b.q = (bf16_t*)(ws + A_Q); b.kv = (bf16_t*)kp->out; b.memkv = (bf16_t*)(ws + A_MEMKV); b.merged = (bf16_t*)kp->out; b.x1b = (bf16_t*)(ws + A_X1B); b.hdn = (bf16_t*)(ws + A_HDN);
    b.x1 = (float*)(ws + A_X1); b.out = kp->out; b.P = (LAS float*)(lds + P_OFF);
    return b;
}
#define WSP(off) ((bf16_t*)(kp->ws + (off)))
#define FRESH() asm volatile("" : "+s"(kp))
#ifndef PHM
#define PHM 0xff
#endif
#ifndef P2M
#define P2M 15
#endif
__global__ void __launch_bounds__(512) mega_fwd(Args a_unused) {
    extern __shared__ __attribute__((aligned(16))) unsigned char lds_raw[];
    cg::grid_group grid = cg::this_grid();
    LAS unsigned char* lds = (LAS unsigned char*)lds_raw;
    const int tid = threadIdx.x, lane = tid & 63, wave = __builtin_amdgcn_readfirstlane(tid >> 6), G = gridDim.x, bid = blockIdx.x;
    KArgP kp = (KArgP)__builtin_amdgcn_kernarg_segment_ptr();
    (void)a_unused;
    volatile LAS unsigned* bst = (volatile LAS unsigned*)(lds + P_OFF + 8192);
    if (tid == 0) { bst[0] = 0u; bst[1] = 0u; }
    if (bid == 0) { unsigned* bw = (unsigned*)(kp->ws + S_BAR); for (int i = tid; i < XCD_BAR_WORDS; i += 512) __hip_atomic_store(bw + i, 0u, RLX_AGENT); }
    __syncthreads();

#ifndef REP_P0
#define REP_P0 1
#endif
#ifndef REP_P6
#define REP_P6 1
#endif
#pragma unroll 1
    for (int rep0 = 0; rep0 < REP_P0; ++rep0) {
        FRESH();
        unsigned char* ws = kp->ws;
        LAS float* scr = (LAS float*)(lds + wave * 16384);
        const int gw = bid * 8 + wave, NGW = G * 8;
        constexpr int I0 = 16 * 168, I1 = 6 * 48, I2 = 4 * 64, I3 = 16 * 32, I4 = 8 * 32, I5 = 16 * 32, I6 = 8 * 32, I7 = 16 * 32, I8 = 16 * 128, I9 = 64 * 32;
        constexpr int NIT = I0 + I1 + I2 + I3 + I4 + I5 + I6 + I7;
        for (int it = gw; it < NIT; it += NGW) {
            int r = it;
            if (r < I0) { transpose_item(kp->in[4], kp->in[3], 1024, 5312, 5376, 0, WSP(W_IN), scr, r, lane); continue; } r -= I0;
            if (r < I1) { transpose_item(kp->in[6], kp->in[5], 384, 1536, 1536, 1, WSP(W_UQ), scr, r, lane); continue; } r -= I1;
            if (r < I2) { transpose_item(kp->in[8], kp->in[7], 256, 2048, 2048, 2, WSP(W_UKV), scr, r, lane); continue; } r -= I2;
            if (r < I3) { transpose_item(kp->in[18], kp->in[17], 1024, 1024, 1024, 3, WSP(W_MKV), scr, r, lane); continue; } r -= I3;
            if (r < I4) { transpose_item(kp->in[21], nullptr, 512, 1024, 1024, 3, WSP(W_OGM), scr, r, lane); continue; } r -= I4;
            if (r < I5) { transpose_item(kp->in[22], nullptr, 1024, 1024, 1024, 3, WSP(W_OMLA), scr, r, lane); continue; } r -= I5;
            if (r < I6) { transpose_item(kp->in[23], nullptr, 512, 1024, 1024, 3, WSP(W_OMEM), scr, r, lane); continue; } r -= I6;
            transpose_item(kp->in[24], nullptr, 1024, 1024, 1024, 3, WSP(W_WOUT), scr, r, lane);
        }
        { const float* x = kp->in[0]; bf16_t* xb = WSP(A_XB); float* rsx = (float*)(ws + S_RSX);
          for (int m = gw; m < T; m += 4 * NGW) rows_to_bf16<4>(x + (size_t)m * 1024, xb + (size_t)m * 1024, rsx + m, NGW, (T - 1 - m) / NGW + 1, lane); }
        { const float* mem = kp->in[1]; bf16_t* memb = WSP(A_MEMB); float* rsm = (float*)(ws + S_RSM);
          for (int m = gw; m < MEMT; m += 4 * NGW) rows_to_bf16<4>(mem + (size_t)m * 1024, memb + (size_t)m * 1024, rsm + m, NGW, (MEMT - 1 - m) / NGW + 1, lane); }
        { const float* wsp = kp->in[15]; bf16_t* wb = WSP(S_WSP);
          for (int idx = bid * 512 + tid; idx < 4 * 128 * 128 / 2; idx += G * 512) { const int e = idx * 2, t = (e >> 7) & 127, sc = e & 127; const f32x2_t w = *(const f32x2_t*)(wsp + e);
              *(unsigned*)(wb + e) = cvtpk(sc <= t ? w[0] : 0.f, sc + 1 <= t ? w[1] : 0.f); } }
        { float* z1 = (float*)(ws + S_SSQCQ); float* z2 = (float*)(ws + S_SSQCKV); float* z3 = (float*)(ws + S_SSQ2);
          for (int i = bid * 512 + tid; i < T; i += G * 512) { z1[i] = 0.f; z2[i] = 0.f; z3[i] = 0.f; } }
        float* rope = (float*)(ws + S_ROPE); const int* pos = (const int*)kp->in[2];
        for (int idx = bid * 512 + tid; idx < T * 32; idx += G * 512) { const int row = idx >> 5, p = idx & 31;
            const float invf = exp2f(-(float)(2 * p) * (13.287712379549449f / 64.0f)); const float ang = (float)pos[row] * invf;
            const double rev = (double)ang * 0.15915494309189535; const float fr_ = (float)(rev - __builtin_rint(rev));
            rope[2 * (size_t)idx] = __builtin_amdgcn_cosf(fr_); rope[2 * (size_t)idx + 1] = __builtin_amdgcn_sinf(fr_); }
    }
    grid.sync();
    const XcdBarrier xbar = xcd_barrier_post((unsigned*)(kp->ws + S_BAR), bst);
    if (PHM & 2) {
#ifndef REP_P1
#define REP_P1 1
#endif
#pragma unroll 1
        for (int r1 = 0; r1 < REP_P1; ++r1) { FRESH(); Bag b = make_bag(kp, lds);
          if (REP_P1 > 1 && r1 + 1 < REP_P1) { b.ssq_cq = (float*)(kp->ws + 48 * MiB); b.ssq_ckv = (float*)(kp->ws + 49 * MiB); }
          pg8::Gemm g{WSP(A_XB), WSP(W_IN), T, 5376, 1024, 1024}; pg8::StaticOrder S; S.init(T, 5376, G, bid); Epi<K_Z> E{b, 0};
          pg8::gemm_phase<Epi<K_Z>, pg8::StaticOrder, true, true, 1024, 1024>(lds, g, S, E); }
        { const int c2 = (bid + 128) % G;
          if (G <= 128 || c2 >= 128) { FRESH(); __syncthreads();
            LAS float* scr = (LAS float*)(lds + wave * 16384);
            const int rank = (G > 128) ? c2 - 128 : bid, nidle = (G > 128) ? G - 128 : G;
            constexpr int I8 = 16 * 128, I9 = 64 * 32;
            for (int it = rank * 8 + wave; it < I8 + I9; it += nidle * 8) {
                if (it < I8) transpose_item(kp->in[26], kp->in[25], 1024, 4096, 4096, 3, WSP(W_FF1), scr, it, lane);
                else transpose_item(kp->in[27], nullptr, 4096, 1024, 1024, 3, WSP(W_FF2), scr, it - I8, lane); }
            __syncthreads(); } }
        { FRESH(); const Bag b = make_bag(kp, lds);
          pg8::Gemm g2{WSP(A_MEMB), WSP(W_MKV), MEMT, 1024, 1024, 1024}; pg8::StaticOrder S2; S2.init(MEMT, 1024, G, (bid + 128) % G); Epi<K_MEMKV> E2{b, 0};
          pg8::gemm_phase<Epi<K_MEMKV>, pg8::StaticOrder, true, true, 1024, 1024>(lds, g2, S2, E2); }
    }
    xcd_barrier(xbar);
    if (PHM & 4) {
#pragma unroll 1
      for (int k2 = 0; k2 < 2; ++k2) { const int part = (bid & 1) ? 1 - k2 : k2;
      if (part == 0) {
#ifndef REP_P2G
#define REP_P2G 1
#endif
#ifndef REP_GM
#define REP_GM 1
#endif
#pragma unroll 1
        for (int rg = 0; rg < REP_P2G; ++rg) {
        if (P2M & 1) { FRESH(); const Bag b = make_bag(kp, lds);
          pg8::Gemm g{b.zCQ, WSP(W_UQ), T, 1536, 384, 512}; pg8::StaticOrder S; S.init(T, 1536, G, bid); Epi<K_Q> E{b, 0};
          pg8::gemm_phase<Epi<K_Q>, pg8::StaticOrder, true, true, 384, 512>(lds, g, S, E); }
        if (P2M & 2) { FRESH(); const Bag b = make_bag(kp, lds);
          pg8::Gemm g2{b.zCKV, WSP(W_UKV), T, 2048, 256, 256}; pg8::StaticOrder S2; S2.init(T, 2048, G, bid); Epi<K_KV> E2{b, 0};
          pg8::gemm_phase<Epi<K_KV>, pg8::StaticOrder, true, true, 256, 256>(lds, g2, S2, E2); }
        }
      } else {
        __syncthreads();
        if (P2M & 4) { FRESH();
#pragma unroll 1
          for (int u = bid; u < 512 * REP_GM; u += G) gmlp_unit((LAS char*)lds, WSP(A_ZU), WSP(A_ZV), kp->in[13], kp->in[14], WSP(S_WSP), kp->in[16], (u & 511) * 128, REP_GM > 1 && u < 512 * (REP_GM - 1)); }
        if (P2M & 8) { FRESH(); bf16_t* zQM = WSP(A_ZQM); const bf16_t* memkv = WSP(A_MEMKV);
#pragma unroll 1
          for (int u0 = bid; u0 < 1024; u0 += G) { int u = u0;
            if (G == 256) { const int L = (u0 >> 8) * 32 + (bid >> 3); u = ((L >> 3) * 8 + (bid & 7)) * 8 + (L & 7); }
            const int bb = u >> 5, hh = (u >> 3) & 3, qb = u & 7;
            bf16_t* Q = zQM + (size_t)bb * SEQ * 512 + hh * 128; const bf16_t* Kp = memkv + (size_t)bb * MEML * 1024 + hh * 128;
            attn_unit<128, false>((LAS char*)lds, Q, 512, nullptr, 0, Kp, 1024, nullptr, 0, Kp + 512, 1024, Q, 512, qb * 256, 4); } }
      }
      __syncthreads();
      }
    }
    xcd_barrier(xbar);
    if (PHM & 8) {
        FRESH(); bf16_t* q = WSP(A_Q); const bf16_t* kv = (const bf16_t*)kp->out; const bf16_t* zCQ = WSP(A_ZCQ);
#ifndef REP_P3
#define REP_P3 1
#endif
#pragma unroll 1
        for (int it = bid; it < 1024 * REP_P3; it += G) { int bh = it & 255, pr = (it >> 8) & 3;
            if (G == 256) { bh = ((bid & 7) + 8 * (bid >> 5)) + 64 * ((it >> 8) & 3); pr = (bid >> 3) & 3; }
            const int bb = bh >> 3, hh = bh & 7;
            bf16_t* Qa = q + (size_t)bb * SEQ * 1536 + hh * 128; const bf16_t* Qb = q + (size_t)bb * SEQ * 1536 + 1024 + hh * 64;
            const bf16_t* Ka = kv + (size_t)bb * SEQ * 2048 + hh * 128; const bf16_t* Kb = zCQ + (size_t)bb * SEQ * 512 + 384; const bf16_t* Vp = Ka + 1024;
            bf16_t* Op = Qa; int pO = 1536;
            if (REP_P3 > 1 && it < 1024 * (REP_P3 - 1)) { Op = WSP(A_ZV) + (size_t)bb * SEQ * 512 + (hh & 3) * 128; pO = 512; }
#pragma unroll 1
            for (int k = 0; k < 2; ++k) { const int qb = k ? 7 - pr : pr;
#if defined(P3ABL)
                if (REP_P3 > 1 && it < 1024 * (REP_P3 - 1)) attn_unit<192, true, P3ABL>((LAS char*)lds, Qa, 1536, Qb, 1536, Ka, 2048, Kb, 512, Vp, 2048, Op, pO, qb * 256, 4 * (qb + 1)); else
#endif
                attn_unit<192, true>((LAS char*)lds, Qa, 1536, Qb, 1536, Ka, 2048, Kb, 512, Vp, 2048, Op, pO, qb * 256, 4 * (qb + 1)); } }
    }
    xcd_barrier(xbar);
    if (PHM & 16) {
        pg8::StaticOrder S; S.init(T, 1024, G, bid);
#ifndef REP_P4
#define REP_P4 1
#endif
#pragma unroll 1
        for (int r4 = 0; r4 < REP_P4; ++r4) {
#pragma unroll 1
        for (int k = 0; k < 3; ++k) {
            const int brn = (k == 2) ? 2 : ((bid & 1) ? 1 - k : k), fl = brn | ((k > 0) << 8);
            FRESH(); const Bag b = make_bag(kp, lds); Epi<K_OUT> E{b, fl};
            if (brn == 1) { pg8::Gemm g{b.q, WSP(W_OMLA), T, 1024, 1024, 1536}; pg8::gemm_phase<Epi<K_OUT>, pg8::StaticOrder, true, true, 1024, 1536>(lds, g, S, E); }
            else { pg8::Gemm g{brn == 0 ? b.zU : b.zQM, brn == 0 ? WSP(W_OGM) : WSP(W_OMEM), T, 1024, 512, 512}; pg8::gemm_phase<Epi<K_OUT>, pg8::StaticOrder, true, true, 512, 512>(lds, g, S, E); }
        }
        }
    }
    xcd_barrier(xbar);
#ifndef REP_P5
#define REP_P5 1
#endif
#pragma unroll 1
    for (int r5 = 0; r5 < REP_P5; ++r5) { FRESH(); Bag b = make_bag(kp, lds); if (REP_P5 > 1 && r5 + 1 < REP_P5) b.ssq2 = (float*)(kp->ws + 48 * MiB); pg8::Gemm g{b.merged, WSP(W_WOUT), T, 1024, 1024, 1024}; pg8::StaticOrder S; S.init(T, 1024, G, bid); Epi<K_WOUT> E{b, 0}; pg8::gemm_phase<Epi<K_WOUT>, pg8::StaticOrder, true, true, 1024, 1024>(lds, g, S, E); }
    xcd_barrier(xbar);
#pragma unroll 1
    for (int rep6 = 0; rep6 < REP_P6; ++rep6) { FRESH(); const Bag b = make_bag(kp, lds); pg8::Gemm g{b.x1b, WSP(W_FF1), T, 4096, 1024, 1024}; pg8::StaticOrder S; S.init(T, 4096, G, bid); Epi<K_FF1> E{b, 0}; pg8::gemm_phase<Epi<K_FF1>, pg8::StaticOrder, true, true, 1024, 1024>(lds, g, S, E); }
    xcd_barrier(xbar);
#ifndef REP_P7
#define REP_P7 1
#endif
#pragma unroll 1
    for (int r7 = 0; r7 < REP_P7; ++r7) { FRESH(); const Bag b = make_bag(kp, lds); pg8::Gemm g{b.hdn, WSP(W_FF2), T, 1024, 4096, 4096}; pg8::StaticOrder S; S.init(T, 1024, G, bid); Epi<K_FF2> E{b, 0}; pg8::gemm_phase<Epi<K_FF2>, pg8::StaticOrder, true, true, 4096, 4096>(lds, g, S, E); }
}

extern "C" void kernel_launch(void* const* d_in, const int* in_sizes, int n_in, void* d_out, int out_size, void* d_ws, size_t ws_size, hipStream_t stream) {
    static int grid_blocks = 0;
    if (grid_blocks == 0) {
        if (n_in != 28 || ws_size < WS_NEED) { fprintf(stderr, "kernel_launch: need 28 inputs and %zu bytes of workspace (got %d, %zu)\n", (size_t)WS_NEED, n_in, ws_size); grid_blocks = -1; return; }
        int dev = 0, cus = 0, per_cu = 0;
        hipGetDevice(&dev); hipDeviceGetAttribute(&cus, hipDeviceAttributeMultiprocessorCount, dev);
        if (hipFuncSetAttribute((const void*)mega_fwd, hipFuncAttributeMaxDynamicSharedMemorySize, LDS_BYTES) != hipSuccess) { fprintf(stderr, "kernel_launch: hipFuncSetAttribute failed\n"); grid_blocks = -1; return; }
        if (hipOccupancyMaxActiveBlocksPerMultiprocessor(&per_cu, (const void*)mega_fwd, 512, LDS_BYTES) != hipSuccess || per_cu < 1) { fprintf(stderr, "kernel_launch: occupancy query gave %d\n", per_cu); per_cu = 1; }
        (void)hipGetLastError();
        grid_blocks = cus * (per_cu > 1 ? 1 : per_cu);
    }
    if (grid_blocks < 0) return;
    Args a{};
    for (int i = 0; i < 28; ++i) a.in[i] = (const float*)d_in[i];
    a.out = (float*)d_out; a.ws = (unsigned char*)d_ws;
    void* args[] = {&a};
    hipError_t e = hipLaunchCooperativeKernel((const void*)mega_fwd, dim3(grid_blocks), dim3(512), args, LDS_BYTES, stream);
    if (e != hipSuccess) fprintf(stderr, "cooperative launch failed: %s (grid %d)\n", hipGetErrorString(e), grid_blocks);
}
```

```cpp
#include <hip/hip_runtime.h>
#include <hip/hip_cooperative_groups.h>
#include <cstdio>
#include <cstdint>
namespace cg = cooperative_groups;
namespace pg8 {
#define PG8_LAS __attribute__((address_space(3)))
typedef unsigned short bf16_t;
typedef short bf16x8 __attribute__((ext_vector_type(8)));
typedef float f32x4 __attribute__((ext_vector_type(4)));
typedef unsigned u32x4 __attribute__((ext_vector_type(4)));
constexpr int BM = 256, BK = 64, HALF = 128, HTB = HALF * BK * 2  , STAGE_BYTES = 8 * HTB, NXCD = 8, WGM = 8;

__host__ __device__ __forceinline__ int lds_byte(int r, int c) { const int st = (r >> 4) * 2 + (c >> 5), rr = r & 15, cc = c & 31, ob = rr * 64 + cc * 2; return st * 1024 + (ob ^ (((ob >> 9) & 1) << 5)); }
__host__ __device__ __forceinline__ void stage_rc(int b, int& R, int& C) { const int st = b / 1024, sb = b % 1024, swz = sb ^ (((sb >> 9) & 1) << 5); R = (st >> 1) * 16 + swz / 64; C = (st & 1) * 32 + (swz % 64) / 2; }
__host__ __device__ __forceinline__ int perm32(int rho) { const int n = rho >> 4, i = rho & 15; return 8 * (i >> 2) + 4 * n + (i & 3); }

struct Unit { int pm, pn; };
struct Gemm { const bf16_t* A; const bf16_t* Bt; int M, N, K, lda; };

struct StaticOrder {
    int nM, nN, nwg, G, c;
    __host__ __device__ void init(int M, int N, int G_, int c_) { nM = M / BM; nN = N / BM; nwg = nM * nN; G = G_; c = c_; }
    __host__ __device__ bool next(int i, Unit& u) const {
        const long L = (long)i * G + c; if (L >= nwg) return false;
        int wgid = (int)L; { const int q = nwg / NXCD, r = nwg % NXCD, xcd = wgid % NXCD, off = wgid / NXCD; wgid = (xcd < r ? xcd * (q + 1) : r * (q + 1) + (xcd - r) * q) + off; }
        const int nig = WGM * nN, gid = wgid / nig, fm = gid * WGM, gsz = (nM - fm) < WGM ? (nM - fm) : WGM;
        u.pm = fm + ((wgid % nig) % gsz); u.pn = (wgid % nig) / gsz; return true;
    }
    __device__ __forceinline__ void a_ready(const Unit&) const {}
    __device__ __forceinline__ void done(const Unit&) const {}
};

template <class Epi, class Sched, bool ALIGN_EPI = false, bool SP2 = false, int KC = 0, int LDAC = 0>
__device__ __forceinline__ void gemm_phase(PG8_LAS unsigned char* lds, const Gemm g, const Sched& S, const Epi& E) {
    int tid_ = threadIdx.x; asm volatile("" : "+v"(tid_));
    const int tid = tid_, wid = __builtin_amdgcn_readfirstlane(tid >> 6), lane = tid & 63, wr = wid >> 2, wc = wid & 3, fr = lane & 15, fq = lane >> 4;
    const int K = KC ? KC : g.K, nt = K / BK, lda_ = LDAC ? LDAC : g.lda;
    unsigned voffA[2], voffB[2];
#pragma unroll
    for (int i = 0; i < 2; ++i) { int R, C; stage_rc(tid * 16 + i * 8192, R, C); const int Rb = Epi::PERM ? ((R & ~31) + perm32(R & 31)) : R;
        voffA[i] = (unsigned)(R * lda_ + C) * 2u; voffB[i] = (unsigned)(Rb * K + C) * 2u; }
    const size_t kstep = (size_t)(BK * 2);
    const size_t hstepA = (size_t)HALF * lda_ * 2, hstepB = (size_t)HALF * K * 2;
    const size_t tstepA = 2 * hstepA, tstepB = 2 * hstepB;
    const unsigned ldsw = (unsigned)wid * 1024u;
    const int aoff = lds_byte(wr * 64 + fr, fq * 8), boff = lds_byte(wc * 32 + fr, fq * 8);
#define PG8_SA(b, h) (((b) * 2 + (h)) * HTB)
#define PG8_SB(b, h) ((4 + (b) * 2 + (h)) * HTB)
#define PG8_STAGE(bufoff, gbase, voff) do { _Pragma("unroll") for (int _i = 0; _i < 2; ++_i) \
        __builtin_amdgcn_global_load_lds((const unsigned*)((const char*)(gbase) + (voff)[_i]), (PG8_LAS unsigned*)(lds + (bufoff) + ldsw + _i * 8192), 16, 0, 0); } while (0)
#define PG8_LDA(dst, b, h) do { _Pragma("unroll") for (int m = 0; m < 4; ++m) _Pragma("unroll") for (int k = 0; k < 2; ++k) dst[m][k] = *(const PG8_LAS bf16x8*)(lds + PG8_SA(b, h) + aoff + m * 2048 + k * 1024); } while (0)
#define PG8_LDB(dst, b, h) do { _Pragma("unroll") for (int n = 0; n < 2; ++n) _Pragma("unroll") for (int k = 0; k < 2; ++k) dst[n][k] = *(const PG8_LAS bf16x8*)(lds + PG8_SB(b, h) + boff + n * 2048 + k * 1024); } while (0)
#define PG8_MMA(ai, bj, At, Bt) do { __builtin_amdgcn_s_setprio(1); _Pragma("unroll") for (int m = 0; m < 4; ++m) _Pragma("unroll") for (int n = 0; n < 2; ++n) _Pragma("unroll") for (int k = 0; k < 2; ++k) \
        acc[ai][bj][m][n] = __builtin_amdgcn_mfma_f32_16x16x32_bf16(Bt[n][k], At[m][k], acc[ai][bj][m][n], 0, 0, 0); __builtin_amdgcn_s_setprio(0); } while (0)
#define PG8_WAIT_V(n) asm volatile("s_waitcnt vmcnt(" #n ")" ::: "memory")
#define PG8_WAIT_L(n) asm volatile("s_waitcnt lgkmcnt(" #n ")" ::: "memory")
#define PG8_BAR __builtin_amdgcn_s_barrier()
#define PG8_SCHED __builtin_amdgcn_sched_barrier(0)
    Unit cur, nxt; int ui = 0;
    if (!S.next(0, cur)) return;
    f32x4 acc[2][2][4][2];
#pragma unroll
    for (int a = 0; a < 2; ++a)
#pragma unroll
        for (int b = 0; b < 2; ++b)
#pragma unroll
            for (int m = 0; m < 4; ++m)
#pragma unroll
                for (int n = 0; n < 2; ++n) acc[a][b][m][n] = (f32x4){0.f, 0.f, 0.f, 0.f};
    bf16x8 At[4][2], B0[2][2], B1[2][2];
    const char* cA = (const char*)g.A + (size_t)cur.pm * tstepA; const char* cB = (const char*)g.Bt + (size_t)cur.pn * tstepB;
    S.a_ready(cur);
    if constexpr (SP2) {
        PG8_STAGE(PG8_SB(0, 0), cB, voffB); PG8_STAGE(PG8_SB(0, 1), cB + hstepB, voffB); PG8_STAGE(PG8_SA(0, 0), cA, voffA); PG8_STAGE(PG8_SA(0, 1), cA + hstepA, voffA);
        if (wr == 1) PG8_BAR;
        PG8_WAIT_V(2); PG8_BAR;
        PG8_STAGE(PG8_SB(1, 0), cB + kstep, voffB); PG8_STAGE(PG8_SA(1, 0), cA + kstep, voffA); PG8_STAGE(PG8_SB(1, 1), cB + hstepB + kstep, voffB);
        PG8_WAIT_V(6); PG8_BAR;
    } else {
        PG8_STAGE(PG8_SB(0, 0), cB, voffB); PG8_STAGE(PG8_SA(0, 0), cA, voffA); PG8_STAGE(PG8_SB(0, 1), cB + hstepB, voffB); PG8_STAGE(PG8_SA(0, 1), cA + hstepA, voffA);
        if (wr == 1) PG8_BAR;
        PG8_WAIT_V(4); PG8_BAR;
        PG8_STAGE(PG8_SB(1, 0), cB + kstep, voffB); PG8_STAGE(PG8_SA(1, 0), cA + kstep, voffA); PG8_STAGE(PG8_SB(1, 1), cB + hstepB + kstep, voffB);
        PG8_WAIT_V(6); PG8_BAR;
    }
    for (;;) {
        const bool has_next = S.next(ui + 1, nxt);
        const char* nA = has_next ? (const char*)g.A + (size_t)nxt.pm * tstepA : cA; const char* nB = has_next ? (const char*)g.Bt + (size_t)nxt.pn * tstepB : cB;
#pragma unroll 1
        for (int t = 0; t < nt; t += 2) {
            const bool last = (t == nt - 2);
            const char* a1 = cA + (size_t)(t + 1) * kstep;
            const char* a2 = last ? nA : cA + (size_t)(t + 2) * kstep; const char* b2 = last ? nB : cB + (size_t)(t + 2) * kstep;
            const char* a3 = a2 + kstep; const char* b3 = b2 + kstep;
            if (last && has_next) S.a_ready(nxt);
            if constexpr (SP2) {
            PG8_LDB(B0, 0, 0); PG8_LDB(B1, 0, 1); PG8_SCHED; PG8_LDA(At, 0, 0); PG8_STAGE(PG8_SA(1, 1), a1 + hstepA, voffA);
            PG8_WAIT_V(8); PG8_WAIT_L(0); PG8_BAR; PG8_MMA(0, 0, At, B0); PG8_MMA(0, 1, At, B1); PG8_BAR; PG8_SCHED;
            PG8_LDA(At, 0, 1); PG8_STAGE(PG8_SB(0, 0), b2, voffB); PG8_STAGE(PG8_SB(0, 1), b2 + hstepB, voffB); PG8_STAGE(PG8_SA(0, 0), a2, voffA);
            PG8_WAIT_V(8); PG8_WAIT_L(0); PG8_BAR; PG8_MMA(1, 0, At, B0); PG8_MMA(1, 1, At, B1); PG8_BAR; PG8_SCHED;
            PG8_LDB(B0, 1, 0); PG8_LDB(B1, 1, 1); PG8_SCHED; PG8_LDA(At, 1, 0); PG8_STAGE(PG8_SA(0, 1), a2 + hstepA, voffA);
            PG8_WAIT_V(8); PG8_WAIT_L(0); PG8_BAR; PG8_MMA(0, 0, At, B0); PG8_MMA(0, 1, At, B1); PG8_BAR; PG8_SCHED;
            PG8_LDA(At, 1, 1); PG8_STAGE(PG8_SB(1, 0), b3, voffB); PG8_STAGE(PG8_SB(1, 1), b3 + hstepB, voffB); PG8_STAGE(PG8_SA(1, 0), a3, voffA);
            PG8_WAIT_V(8); PG8_WAIT_L(0); PG8_BAR; PG8_MMA(1, 0, At, B0); PG8_MMA(1, 1, At, B1); PG8_BAR; PG8_SCHED;
            } else {
            PG8_LDB(B0, 0, 0); PG8_SCHED; PG8_LDA(At, 0, 0); PG8_STAGE(PG8_SA(1, 1), a1 + hstepA, voffA);
            PG8_WAIT_L(8); PG8_BAR; PG8_WAIT_L(0); PG8_MMA(0, 0, At, B0); PG8_BAR; PG8_SCHED;
            PG8_LDB(B1, 0, 1); PG8_STAGE(PG8_SB(0, 0), b2, voffB);
            PG8_BAR; PG8_WAIT_L(0); PG8_MMA(0, 1, At, B1); PG8_BAR;
            PG8_LDA(At, 0, 1); PG8_STAGE(PG8_SA(0, 0), a2, voffA);
            PG8_BAR; PG8_WAIT_L(0); PG8_MMA(1, 0, At, B0); PG8_BAR; PG8_SCHED;
            PG8_STAGE(PG8_SB(0, 1), b2 + hstepB, voffB);
            PG8_WAIT_V(6); PG8_BAR; PG8_MMA(1, 1, At, B1); PG8_BAR;
            PG8_LDB(B0, 1, 0); PG8_SCHED; PG8_LDA(At, 1, 0); PG8_STAGE(PG8_SA(0, 1), a2 + hstepA, voffA);
            PG8_WAIT_L(8); PG8_BAR; PG8_WAIT_L(0); PG8_MMA(0, 0, At, B0); PG8_BAR; PG8_SCHED;
            PG8_LDB(B1, 1, 1); PG8_STAGE(PG8_SB(1, 0), b3, voffB);
            PG8_BAR; PG8_WAIT_L(0); PG8_MMA(0, 1, At, B1); PG8_BAR;
            PG8_LDA(At, 1, 1); PG8_STAGE(PG8_SA(1, 0), a3, voffA);
            PG8_BAR; PG8_WAIT_L(0); PG8_MMA(1, 0, At, B0); PG8_BAR; PG8_SCHED;
            PG8_STAGE(PG8_SB(1, 1), b3 + hstepB, voffB);
            PG8_WAIT_V(6); PG8_BAR; PG8_MMA(1, 1, At, B1); PG8_BAR;
            }
        }
        if constexpr (ALIGN_EPI) { if (wr == 0) PG8_BAR; }
        if constexpr (!Epi::AFTER_DRAIN) { E(acc, cur, wr, wc, fr, fq); S.done(cur); }
        if (!has_next) break;
#pragma unroll
        for (int a = 0; a < 2; ++a)
#pragma unroll
            for (int b = 0; b < 2; ++b)
#pragma unroll
                for (int m = 0; m < 4; ++m)
#pragma unroll
                    for (int n = 0; n < 2; ++n) acc[a][b][m][n] = (f32x4){0.f, 0.f, 0.f, 0.f};
        cur = nxt; cA = nA; cB = nB; ++ui;
        if constexpr (ALIGN_EPI) { if (wr == 1) PG8_BAR; }
    }
    PG8_WAIT_V(0);
    if constexpr (!ALIGN_EPI) { if (wr == 0) PG8_BAR; }
    PG8_BAR;
    if constexpr (Epi::AFTER_DRAIN) { E.fused(acc, cur, wr, wc, fr, fq, lds, wid, lane); S.done(cur); }
#undef PG8_SA
#undef PG8_SB
#undef PG8_STAGE
#undef PG8_LDA
#undef PG8_LDB
#undef PG8_MMA
#undef PG8_WAIT_V
#undef PG8_WAIT_L
#undef PG8_BAR
#undef PG8_SCHED
}
}

#define LAS __attribute__((address_space(3)))
#define DI __device__ __forceinline__
using pg8::bf16_t; using pg8::bf16x8; using pg8::f32x4; using pg8::u32x4;
typedef short s16x4 __attribute__((ext_vector_type(4)));
typedef short v4i16_t __attribute__((ext_vector_type(4)));
typedef float f32x16 __attribute__((ext_vector_type(16)));
typedef float f32x2_t __attribute__((ext_vector_type(2)));
typedef __bf16 bf16x2_t __attribute__((ext_vector_type(2)));
typedef unsigned u32x2 __attribute__((ext_vector_type(2)));

constexpr int T = 65536, SEQ = 2048, NB = 32, DM = 1024, MEMT = 8192, MEML = 256;
constexpr float EPSN = 1e-6f, LOG2E = 1.4426950408889634f;
constexpr size_t MiB = 1u << 20;
constexpr size_t W_IN = 0, W_UQ = 11 * MiB, W_UKV = 13 * MiB, W_MKV = 14 * MiB, W_OGM = 16 * MiB, W_OMLA = 17 * MiB, W_OMEM = 19 * MiB, W_WOUT = 20 * MiB, W_FF1 = 22 * MiB, W_FF2 = 30 * MiB;
constexpr size_t S_WSP = 39 * MiB + 512 * 1024;
constexpr size_t S_BAR = 39 * MiB;
constexpr size_t S_RSX = 40 * MiB, S_RSM = S_RSX + 256 * 1024, S_SSQCQ = 41 * MiB, S_SSQCKV = 44 * MiB, S_SSQ2 = 46 * MiB, S_ROPE = 50 * MiB;
constexpr size_t A_ZU = 72 * MiB, A_ZV = 136 * MiB, A_X1B = 72 * MiB, A_MEMB = 200 * MiB, A_MEMKV = 216 * MiB, A_Q = 232 * MiB, A_XB = 232 * MiB;
constexpr size_t A_ZCQ = 424 * MiB, A_ZCKV = 488 * MiB, A_ZQM = 520 * MiB, A_ZG = 584 * MiB, A_HDN = 200 * MiB, A_X1 = 712 * MiB, WS_NEED = 968 * MiB;
constexpr int RING_BYTES = 131072, P_OFF = RING_BYTES, LDS_BYTES = 147456;

DI unsigned cvtpk(float lo, float hi) { f32x2_t v = {lo, hi}; bf16x2_t b = __builtin_convertvector(v, bf16x2_t); return __builtin_bit_cast(unsigned, b); }
DI float bflo(unsigned w) { return __uint_as_float(w << 16); }
DI float bfhi(unsigned w) { return __uint_as_float(w & 0xffff0000u); }
DI float wave_sum(float v) {
    v += __builtin_bit_cast(float, __builtin_amdgcn_update_dpp(0, __builtin_bit_cast(int, v), 0x121, 0xf, 0xf, false));
    v += __builtin_bit_cast(float, __builtin_amdgcn_update_dpp(0, __builtin_bit_cast(int, v), 0x122, 0xf, 0xf, false));
    v += __builtin_bit_cast(float, __builtin_amdgcn_update_dpp(0, __builtin_bit_cast(int, v), 0x124, 0xf, 0xf, false));
    v += __builtin_bit_cast(float, __builtin_amdgcn_update_dpp(0, __builtin_bit_cast(int, v), 0x128, 0xf, 0xf, false));
    { const auto r = __builtin_amdgcn_permlane16_swap(__float_as_uint(v), __float_as_uint(v), false, false); v = __uint_as_float(r[0]) + __uint_as_float(r[1]); }
    { const auto r = __builtin_amdgcn_permlane32_swap(__float_as_uint(v), __float_as_uint(v), false, false); v = __uint_as_float(r[0]) + __uint_as_float(r[1]); }
    return v;
}
DI float xsum16(float s) { const auto r = __builtin_amdgcn_permlane16_swap(__float_as_uint(s), __float_as_uint(s), false, false); return __uint_as_float(r[0]) + __uint_as_float(r[1]); }
DI float xsum32(float s) { const auto r = __builtin_amdgcn_permlane32_swap(__float_as_uint(s), __float_as_uint(s), false, false); return __uint_as_float(r[0]) + __uint_as_float(r[1]); }
DI float xmax32(float s) { const auto r = __builtin_amdgcn_permlane32_swap(__float_as_uint(s), __float_as_uint(s), false, false); return fmaxf(__uint_as_float(r[0]), __uint_as_float(r[1])); }
DI float gelu_t(float x) { const float t = x + 0.044715f * x * x * x; return x * __builtin_amdgcn_rcpf(1.0f + __builtin_amdgcn_exp2f(-2.3022082f * t)); }
DI float sigm(float x) { return __builtin_amdgcn_rcpf(1.0f + __builtin_amdgcn_exp2f(-LOG2E * x)); }
DI void st8(bf16_t* p, const float (&v)[8]) { u32x4 w; w.x = cvtpk(v[0], v[1]); w.y = cvtpk(v[2], v[3]); w.z = cvtpk(v[4], v[5]); w.w = cvtpk(v[6], v[7]); *(u32x4*)p = w; }
DI void ld8f(const float* p, float (&v)[8]) { const f32x4 a = *(const f32x4*)p, b = *(const f32x4*)(p + 4); v[0] = a[0]; v[1] = a[1]; v[2] = a[2]; v[3] = a[3]; v[4] = b[0]; v[5] = b[1]; v[6] = b[2]; v[7] = b[3]; }
DI void ld8b(const bf16_t* p, float (&v)[8]) { const u32x4 w = *(const u32x4*)p; v[0] = bflo(w.x); v[1] = bfhi(w.x); v[2] = bflo(w.y); v[3] = bfhi(w.y); v[4] = bflo(w.z); v[5] = bfhi(w.z); v[6] = bflo(w.w); v[7] = bfhi(w.w); }
#define EPI_BAR() do { asm volatile("s_waitcnt lgkmcnt(0)" ::: "memory"); __builtin_amdgcn_s_barrier(); asm volatile("" ::: "memory"); } while (0)

struct Bag {
    const float *x, *g_qn, *g_qp, *g_kn, *g_kp, *g_mq, *g_mk;
    float *rstd_x, *rstd_mem, *ssq_cq, *ssq_ckv, *ssq2; const float* rope;
    bf16_t *zU, *zV, *zCQ, *zCKV, *zQM, *zG, *q, *kv, *memkv, *merged, *x1b, *hdn;
    float *x1, *out;
    LAS float* P;
};
typedef f32x4 AccT[2][2][4][2];
#define ACC8(v, ai, bj, m, s) do { const f32x4 a_ = acc[ai][bj][m][0] * (s), b_ = acc[ai][bj][m][1] * (s); v[0] = a_[0]; v[1] = a_[1]; v[2] = a_[2]; v[3] = a_[3]; v[4] = b_[0]; v[5] = b_[1]; v[6] = b_[2]; v[7] = b_[3]; } while (0)
DI float ssq8(const float (&v)[8]) { float s = (v[0] * v[0] + v[1] * v[1]) + (v[2] * v[2] + v[3] * v[3]) + (v[4] * v[4] + v[5] * v[5]) + (v[6] * v[6] + v[7] * v[7]); s = xsum16(s); s = xsum32(s); return s; }

template <int NS> DI void row_scales(const float* rsp, float inv, int grow0, float (&rs)[8]) {
#pragma unroll
    for (int it = 0; it < 8; ++it) rs[it] = rsp[grow0 + (it >> 2) * 128 + (it & 3) * 16];
    if (NS != 0) {
#pragma unroll
        for (int it = 0; it < 8; ++it) rs[it] = __builtin_amdgcn_rsqf(rs[it] * inv + EPSN); }
}
template <int GS, bool ROPE, int NS>
DI void headnorm(const AccT& acc, const float* rsp, float rs_inv, const float* gain, float oscale, bf16_t* dst, int ld, int grow0, int bj_lo,
                 int wr, int wc, int fr, int fq, LAS float* P, const float* rope) {
    const int rowl0 = wr * 64 + fr, cl0 = wc * 32 + 8 * fq, ch = cl0 & (GS - 1);
#pragma unroll
    for (int ai = 0; ai < 2; ++ai)
#pragma unroll
        for (int m = 0; m < 4; ++m)
#pragma unroll
            for (int bj = 0; bj < 2; ++bj) { if (bj < bj_lo) continue; float v[8]; ACC8(v, ai, bj, m, 1.0f); const float s = ssq8(v);
                if (fq == 0) P[(ai * 128 + m * 16 + rowl0) * 8 + bj * 4 + wc] = s; }
    EPI_BAR();
    float rs[8]; row_scales<NS>(rsp, rs_inv, grow0, rs);
    float g8[8];
    if (ROPE) { const int p0 = ch >> 1;
#pragma unroll
        for (int e = 0; e < 8; ++e) g8[e] = gain[(e & 1) * 32 + p0 + (e >> 1)] * oscale;
    } else { ld8f(gain + ch, g8);
#pragma unroll
        for (int e = 0; e < 8; ++e) g8[e] *= oscale; }
    f32x4 cs[4][2];
#define CS_LOAD(itn) do { const size_t gn_ = (size_t)(grow0 + ((itn) >> 2) * 128 + ((itn) & 3) * 16); cs[(itn) & 3][0] = *(const f32x4*)(rope + gn_ * 64 + ch); cs[(itn) & 3][1] = *(const f32x4*)(rope + gn_ * 64 + ch + 4); } while (0)
    if (ROPE) { CS_LOAD(0); CS_LOAD(1); CS_LOAD(2); CS_LOAD(3); }
#pragma unroll
    for (int it = 0; it < 8; ++it) { const int ai = it >> 2, m = it & 3, rl = ai * 128 + m * 16 + rowl0; const size_t grow = (size_t)(grow0 + ai * 128 + m * 16);
        __builtin_amdgcn_sched_barrier(0);
#pragma unroll
        for (int bj = 0; bj < 2; ++bj) { if (bj < bj_lo) continue;
            const f32x4 p4 = *(const LAS f32x4*)(P + rl * 8 + bj * 4);
            const float tot = ((GS == 128) ? (p4[0] + p4[1]) + (p4[2] + p4[3]) : (wc < 2 ? p4[0] + p4[1] : p4[2] + p4[3])) * rs[it] * rs[it];
            const float r = __builtin_amdgcn_rsqf(tot * (1.0f / GS) + EPSN) * rs[it];
            float v[8]; ACC8(v, ai, bj, m, r);
#pragma unroll
            for (int e = 0; e < 8; ++e) v[e] *= g8[e];
            if (ROPE) { const f32x4 c0 = cs[it & 3][0], c1 = cs[it & 3][1]; const float cv[8] = {c0[0], c0[1], c0[2], c0[3], c1[0], c1[1], c1[2], c1[3]};
#pragma unroll
                for (int k = 0; k < 4; ++k) { const float a = v[2 * k], b = v[2 * k + 1], c = cv[2 * k], sn = cv[2 * k + 1]; v[2 * k] = a * c - b * sn; v[2 * k + 1] = b * c + a * sn; } }
            st8(dst + grow * ld + bj * 128 + cl0, v); }
        __builtin_amdgcn_sched_barrier(0); if (ROPE && it + 4 < 8) CS_LOAD(it + 4); __builtin_amdgcn_sched_barrier(0); }
#undef CS_LOAD
}

enum { K_Z = 0, K_MEMKV, K_Q, K_KV, K_OUT, K_WOUT, K_FF1, K_FF2 };
template <int KIND> struct Epi {
    static constexpr bool PERM = true, AFTER_DRAIN = false;
    Bag b; int br;
    DI void operator()(const AccT& acc, const pg8::Unit& u, int wr, int wc, int fr_in, int fq_in) const {
        int ln_; asm volatile("v_mbcnt_lo_u32_b32 %0, -1, 0\n\tv_mbcnt_hi_u32_b32 %0, -1, %0" : "=v"(ln_));
        const int fr = ln_ & 15, fq = ln_ >> 4; (void)fr_in; (void)fq_in;
        const int grow0 = u.pm * 256 + wr * 64 + fr, cl0 = wc * 32 + 8 * fq, pn = u.pn, tc0 = pn * 256 + cl0;
#define IT_AI (it >> 2)
#define IT_M (it & 3)
#define IT_ROW ((size_t)(grow0 + (it >> 2) * 128 + (it & 3) * 16))
#define ITLOOP _Pragma("unroll") for (int it = 0; it < 8; ++it)
#define BJLOOP _Pragma("unroll") for (int bj = 0; bj < 2; ++bj)
#define SBE() __builtin_amdgcn_sched_barrier(0)
        if (KIND == K_Z) {
            float rs[8]; row_scales<0>(b.rstd_x, 0.f, grow0, rs);
            if (pn < 4) { bf16_t* dst = (pn < 2 ? b.zU : b.zV) + (pn & 1) * 256 + cl0;
                ITLOOP { BJLOOP { float v[8]; ACC8(v, IT_AI, bj, IT_M, rs[it]);
#pragma unroll
                    for (int e = 0; e < 8; ++e) v[e] = gelu_t(v[e]);
                    st8(dst + IT_ROW * 512 + bj * 128, v); } SBE(); }
            } else if (pn == 4 || pn == 6) { bf16_t* dst = (pn == 4 ? b.zCQ : b.zCKV) + cl0; const int ld = (pn == 4) ? 512 : 256; float* sq = (pn == 4) ? b.ssq_cq : b.ssq_ckv;
                ITLOOP { float s = 0.f; BJLOOP { float v[8]; ACC8(v, IT_AI, bj, IT_M, rs[it]); s += ssq8(v); st8(dst + IT_ROW * ld + bj * 128, v); } if (fq == 0) __hip_atomic_fetch_add(sq + IT_ROW, s, __ATOMIC_RELAXED, __HIP_MEMORY_SCOPE_AGENT); SBE(); }
            } else if (pn == 5) {
                ITLOOP { float v[8]; ACC8(v, IT_AI, 0, IT_M, rs[it]); const float s = ssq8(v); st8(b.zCQ + IT_ROW * 512 + 256 + cl0, v); if (fq == 0) __hip_atomic_fetch_add(b.ssq_cq + IT_ROW, s, __ATOMIC_RELAXED, __HIP_MEMORY_SCOPE_AGENT); SBE(); }
                headnorm<64, true, 0>(acc, b.rstd_x, 0.f, b.g_kp, 1.0f, b.zCQ + 256, 512, grow0, 1, wr, wc, fr, fq, b.P, b.rope);
            } else if (pn < 9) {
                headnorm<128, false, 0>(acc, b.rstd_x, 0.f, b.g_mq, LOG2E * 0.08838834764831845f, b.zQM + (pn - 7) * 256, 512, grow0, 0, wr, wc, fr, fq, b.P, nullptr);
            } else { bf16_t* dst = b.zG + (pn - 9) * 256 + cl0;
                ITLOOP { BJLOOP { float v[8]; ACC8(v, IT_AI, bj, IT_M, rs[it]);
#pragma unroll
                    for (int e = 0; e < 8; ++e) v[e] = sigm(v[e]);
                    st8(dst + IT_ROW * 3072 + bj * 128, v); } SBE(); }
            }
        }
        if (KIND == K_MEMKV) {
            if (pn < 2) headnorm<128, false, 0>(acc, b.rstd_mem, 0.f, b.g_mk, 1.0f, b.memkv + pn * 256, 1024, grow0, 0, wr, wc, fr, fq, b.P, nullptr);
            else { float rs[8]; row_scales<0>(b.rstd_mem, 0.f, grow0, rs); ITLOOP { BJLOOP { float v[8]; ACC8(v, IT_AI, bj, IT_M, rs[it]); st8(b.memkv + IT_ROW * 1024 + tc0 + bj * 128, v); } SBE(); } }
        }
        if (KIND == K_Q) {
            const float qs = LOG2E * 0.07216878364870323f;
            if (pn < 4) headnorm<128, false, 1>(acc, b.ssq_cq, 1.0f / 384.0f, b.g_qn, qs, b.q + pn * 256, 1536, grow0, 0, wr, wc, fr, fq, b.P, nullptr);
            else headnorm<64, true, 1>(acc, b.ssq_cq, 1.0f / 384.0f, b.g_qp, qs, b.q + pn * 256, 1536, grow0, 0, wr, wc, fr, fq, b.P, b.rope);
        }
        if (KIND == K_KV) {
            if (pn < 4) headnorm<128, false, 1>(acc, b.ssq_ckv, 1.0f / 256.0f, b.g_kn, 1.0f, b.kv + pn * 256, 2048, grow0, 0, wr, wc, fr, fq, b.P, nullptr);
            else { float rs[8]; row_scales<1>(b.ssq_ckv, 1.0f / 256.0f, grow0, rs); ITLOOP { BJLOOP { float v[8]; ACC8(v, IT_AI, bj, IT_M, rs[it]); st8(b.kv + IT_ROW * 2048 + tc0 + bj * 128, v); } SBE(); } }
        }
        if (KIND == K_OUT) {
            const int brn = br & 3; const bool accum = (br >> 8) != 0;
            u32x4 pg[4][2], pm[4][2];
#define OUT_LOAD(itn, buf) do { const size_t rw_ = (size_t)(grow0 + ((itn) >> 2) * 128 + ((itn) & 3) * 16); BJLOOP { pg[buf][bj] = *(const u32x4*)(b.zG + rw_ * 3072 + brn * 1024 + tc0 + bj * 128); \
                if (accum) pm[buf][bj] = *(const u32x4*)(b.merged + rw_ * 1024 + tc0 + bj * 128); } } while (0)
            OUT_LOAD(0, 0); OUT_LOAD(1, 1); OUT_LOAD(2, 2); OUT_LOAD(3, 3); SBE();
            ITLOOP {
                BJLOOP { const u32x4 gw = pg[it & 3][bj]; const float g[8] = {bflo(gw.x), bfhi(gw.x), bflo(gw.y), bfhi(gw.y), bflo(gw.z), bfhi(gw.z), bflo(gw.w), bfhi(gw.w)};
                    float v[8]; ACC8(v, IT_AI, bj, IT_M, 1.0f);
                    if (accum) { const u32x4 ow = pm[it & 3][bj]; const float o[8] = {bflo(ow.x), bfhi(ow.x), bflo(ow.y), bfhi(ow.y), bflo(ow.z), bfhi(ow.z), bflo(ow.w), bfhi(ow.w)};
#pragma unroll
                        for (int e = 0; e < 8; ++e) v[e] = o[e] + g[e] * v[e];
                    } else {
#pragma unroll
                        for (int e = 0; e < 8; ++e) v[e] = g[e] * v[e]; }
                    st8(b.merged + IT_ROW * 1024 + tc0 + bj * 128, v); }
                SBE(); if (it + 4 < 8) OUT_LOAD(it + 4, it & 3); SBE(); }
#undef OUT_LOAD
        }
        if (KIND == K_WOUT) {
            f32x4 px[4][2][2];
#define RES_LOAD(itn, buf) do { const float* p_ = b.x + (size_t)(grow0 + ((itn) >> 2) * 128 + ((itn) & 3) * 16) * 1024 + tc0; BJLOOP { px[buf][bj][0] = *(const f32x4*)(p_ + bj * 128); px[buf][bj][1] = *(const f32x4*)(p_ + bj * 128 + 4); } } while (0)
            RES_LOAD(0, 0); RES_LOAD(1, 1); RES_LOAD(2, 2); RES_LOAD(3, 3); SBE();
            ITLOOP {
                float s = 0.f;
                BJLOOP { float v[8]; ACC8(v, IT_AI, bj, IT_M, 1.0f); const f32x4 x0 = px[it & 3][bj][0], x1v = px[it & 3][bj][1];
                    v[0] += x0[0]; v[1] += x0[1]; v[2] += x0[2]; v[3] += x0[3]; v[4] += x1v[0]; v[5] += x1v[1]; v[6] += x1v[2]; v[7] += x1v[3];
#pragma unroll
                    for (int e = 0; e < 8; ++e) s += v[e] * v[e];
                    st8(b.x1b + IT_ROW * 1024 + tc0 + bj * 128, v); }
                s = xsum16(s); s = xsum32(s); if (fq == 0) __hip_atomic_fetch_add(b.ssq2 + IT_ROW, s, __ATOMIC_RELAXED, __HIP_MEMORY_SCOPE_AGENT);
                SBE(); if (it + 4 < 8) RES_LOAD(it + 4, it & 3); SBE(); }
#undef RES_LOAD
        }
        if (KIND == K_FF2) {
            u32x4 px[4][2];
#define RES_LOAD(itn, buf) do { const bf16_t* p_ = b.x1b + (size_t)(grow0 + ((itn) >> 2) * 128 + ((itn) & 3) * 16) * 1024 + tc0; BJLOOP { px[buf][bj] = *(const u32x4*)(p_ + bj * 128); } } while (0)
            RES_LOAD(0, 0); RES_LOAD(1, 1); RES_LOAD(2, 2); RES_LOAD(3, 3); SBE();
            ITLOOP {
                BJLOOP { float v[8]; ACC8(v, IT_AI, bj, IT_M, 1.0f); const u32x4 w = px[it & 3][bj];
                    float* op = b.out + IT_ROW * 1024 + tc0 + bj * 128;
                    *(f32x4*)op = (f32x4){v[0] + bflo(w.x), v[1] + bfhi(w.x), v[2] + bflo(w.y), v[3] + bfhi(w.y)}; *(f32x4*)(op + 4) = (f32x4){v[4] + bflo(w.z), v[5] + bfhi(w.z), v[6] + bflo(w.w), v[7] + bfhi(w.w)}; }
                SBE(); if (it + 4 < 8) RES_LOAD(it + 4, it & 3); SBE(); }
#undef RES_LOAD
        }
        if (KIND == K_FF1) {
            float rs[8]; row_scales<1>(b.ssq2, 1.0f / 1024.0f, grow0, rs);
            ITLOOP { BJLOOP { float v[8]; ACC8(v, IT_AI, bj, IT_M, rs[it]);
#pragma unroll
                for (int e = 0; e < 8; ++e) { const float t = fmaxf(v[e], 0.f); v[e] = t * t; }
                st8(b.hdn + IT_ROW * 4096 + tc0 + bj * 128, v); } SBE(); }
        }
#undef IT_AI
#undef IT_M
#undef IT_ROW
#undef ITLOOP
#undef BJLOOP
#undef SBE
    }
};

DI int crow(int r, int hi) { return (r & 3) + 8 * (r >> 2) + 4 * hi; }
DI s16x4 vtr(const LAS char* p) { return __builtin_bit_cast(s16x4, __builtin_amdgcn_ds_read_tr16_b64_v4i16((LAS v4i16_t*)p)); }
#define MFMA32(a, b, c) __builtin_amdgcn_mfma_f32_32x32x16_bf16((a), (b), (c), 0, 0, 0)
DI bf16x8 pack8(const f32x16& x, int o) { u32x4 w; w.x = cvtpk(x[o], x[o + 1]); w.y = cvtpk(x[o + 2], x[o + 3]); w.z = cvtpk(x[o + 4], x[o + 5]); w.w = cvtpk(x[o + 6], x[o + 7]); return __builtin_bit_cast(bf16x8, w); }

template <int DQK, bool CAUSAL, int ABL = 0>
DI void attn_unit(LAS char* lds, const bf16_t* Qa, int pQa, const bf16_t* Qb, int pQb, const bf16_t* Ka, int pKa, const bf16_t* Kb, int pKb,
                  const bf16_t* V, int pV, bf16_t* O, int pO, int q0, int NT) {
    constexpr int KP = DQK * 2 + 16, VP = 320, KBUF = 64 * KP, VBUF = 64 * VP, SLOT = KBUF + VBUF, NDS = DQK / 16, KB = (DQK == 192) ? 2 : 4, NKB = NDS / KB;
    constexpr float THR = 8.0f;
    constexpr int KC16 = KP / 16, NKC = KBUF / 1024, NVC = VBUF / 1024, NCH = NKC + NVC, NOPS = (NCH + 7) / 8;
    static_assert(KBUF % 1024 == 0 && VBUF % 1024 == 0 && 3 * SLOT <= P_OFF + 8192 && (NOPS == 5 || NOPS == 6), "attention ring geometry");
    int tid_ = threadIdx.x; asm volatile("" : "+v"(tid_));
    const int tid = tid_, lane = tid & 63, wid = __builtin_amdgcn_readfirstlane(tid >> 6), r = lane & 31, h = lane >> 5;
    const size_t qrow = (size_t)(q0 + 32 * wid + r);
    asm volatile("s_waitcnt lgkmcnt(0)\n\ts_barrier" ::: "memory");
    const char* gp[NOPS]; unsigned ginc[NOPS]; int loff[NOPS];
#pragma unroll
    for (int j = 0; j < NOPS; ++j) { const int c = (wid + 8 * j < NCH) ? wid + 8 * j : NCH - 1; loff[j] = c * 1024;
        if (c < NKC) { const int idx = 64 * c + lane, row = idx / KC16, cb = idx - row * KC16;
            if (DQK == 192 && cb >= 16 && cb < 24) { gp[j] = (const char*)(Kb + (size_t)row * pKb + (cb - 16) * 8); ginc[j] = 64u * (unsigned)pKb * 2u; }
            else { gp[j] = (const char*)(Ka + (size_t)row * pKa + (cb < 16 ? cb * 8 : 0)); ginc[j] = 64u * (unsigned)pKa * 2u; }
        } else { const int idx = 64 * (c - NKC) + lane, row = idx / 20, cb = idx - row * 20;
            gp[j] = (const char*)(V + (size_t)row * pV + (cb < 16 ? cb * 8 : 0)); ginc[j] = 64u * (unsigned)pV * 2u; } }
#define AT_ISSUE(slot) do { if (ABL & 8) break; _Pragma("unroll") for (int j = 0; j < NOPS; ++j) { \
        __builtin_amdgcn_global_load_lds((const unsigned*)gp[j], (LAS unsigned*)(lds + (slot) * SLOT + loff[j]), 16, 0, 0); gp[j] += ginc[j]; } } while (0)
#define AT_WAITBAR(n) asm volatile("s_waitcnt vmcnt(" #n ") lgkmcnt(0)\n\ts_barrier" ::: "memory")
#define AT_WAIT_NEWEST() do { if (NOPS == 6) AT_WAITBAR(6); else AT_WAITBAR(5); } while (0)
#define SB() __builtin_amdgcn_sched_barrier(0)
#define LDK(dst, bi) do { _Pragma("unroll") for (int j = 0; j < KB; ++j) { dst[2 * j] = *(const LAS bf16x8*)(kb_ + ((bi) * KB + j) * 32); dst[2 * j + 1] = *(const LAS bf16x8*)(kb_ + 32 * KP + ((bi) * KB + j) * 32); } } while (0)
#define MMK(src, bi) do { _Pragma("unroll") for (int j = 0; j < KB; ++j) { \
        if ((bi) == 0 && j == 0) { s0 = MFMA32(src[0], qf[0], negm); s1 = MFMA32(src[1], qf[0], negm); } \
        else { s0 = MFMA32(src[2 * j], qf[(bi) * KB + j], s0); s1 = MFMA32(src[2 * j + 1], qf[(bi) * KB + j], s1); } } } while (0)
#define TRR(dst, off) asm volatile("ds_read_b64_tr_b16 %0, %1 offset:%c2" : "=&v"(dst) : "v"(va_), "i"(off) : "memory")
#define LDV(lo, hi, s) do { _Pragma("unroll") for (int d = 0; d < 4; ++d) { TRR(lo[d], (16 * (s)) * VP + d * 64); TRR(hi[d], (16 * (s) + 8) * VP + d * 64); } } while (0)
#define MMV(lo, hi, s) do { if (ABL & 4) { _Pragma("unroll") for (int d = 0; d < 4; ++d) o[d][0] += (float)lo[d][0] + (float)hi[d][0] + (float)pf[s][d]; break; } _Pragma("unroll") for (int d = 0; d < 4; ++d) o[d] = MFMA32(((bf16x8){lo[d][0], lo[d][1], lo[d][2], lo[d][3], hi[d][0], hi[d][1], hi[d][2], hi[d][3]}), pf[s], o[d]); } while (0)
#define LGKM(n) asm volatile("s_waitcnt lgkmcnt(" #n ")" ::: "memory")
    AT_ISSUE(0);
    if (NT > 1) AT_ISSUE(1);
    bf16x8 qf[NDS];
#pragma unroll
    for (int ds = 0; ds < 8; ++ds) qf[ds] = *(const bf16x8*)(Qa + qrow * pQa + 16 * ds + 8 * h);
    if (DQK == 192) {
#pragma unroll
        for (int ds = 8; ds < NDS; ++ds) qf[ds] = *(const bf16x8*)(Qb + qrow * pQb + 16 * (ds - 8) + 8 * h); }
    AT_WAITBAR(0);
    float mhat = 0.f, lsum = 0.f;
    f32x16 negm;
#pragma unroll
    for (int i = 0; i < 16; ++i) negm[i] = 0.f;
    f32x16 o[4];
#pragma unroll
    for (int d = 0; d < 4; ++d)
#pragma unroll
        for (int i = 0; i < 16; ++i) o[d][i] = 0.f;
    const int qmin = q0 + 32 * wid, qpos = qmin + r;
    const int q4 = (lane & 15) >> 2, p4 = lane & 3, blk = (lane >> 4) & 1;
    int sc = 0, sn2 = 2;
#pragma unroll 1
    for (int t = 0; t < NT; ++t) {
        if (t + 2 < NT) AT_ISSUE(sn2);
        const bool active = !CAUSAL || (64 * t <= qmin + 31);
        if (active) {
            const LAS char* kb_ = lds + sc * SLOT + r * KP + 16 * h; const LAS char* vb_ = lds + sc * SLOT + KBUF + (4 * h + q4) * VP + blk * 32 + p4 * 8;
            f32x16 s0, s1;
            bf16x8 fa[2 * KB], fb[2 * KB];
            SB(); LDK(fa, 0); SB();
#pragma unroll
            for (int bi = 0; bi < NKB; ++bi) {
                if (bi & 1) { if (bi + 1 < NKB) LDK(fa, bi + 1); SB(); MMK(fb, bi); SB(); }
                else { if (bi + 1 < NKB) LDK(fb, bi + 1); SB(); MMK(fa, bi); SB(); } }
            if (CAUSAL && (64 * t + 63 > qmin)) {
#pragma unroll
                for (int i = 0; i < 16; ++i) { const int kv = 64 * t + crow(i, h); if (kv > qpos) s0[i] = -INFINITY; if (kv + 32 > qpos) s1[i] = -INFINITY; } }
            float a_ = fmaxf(fmaxf(s0[0], s0[1]), s1[0]), b_ = fmaxf(fmaxf(s0[2], s0[3]), s1[1]); a_ = fmaxf(fmaxf(a_, s1[2]), s1[3]);
#pragma unroll
            for (int i = 4; i < 16; i += 4) { a_ = fmaxf(fmaxf(a_, s0[i]), s0[i + 1]); b_ = fmaxf(fmaxf(b_, s0[i + 2]), s0[i + 3]); a_ = fmaxf(fmaxf(a_, s1[i]), s1[i + 1]); b_ = fmaxf(fmaxf(b_, s1[i + 2]), s1[i + 3]); }
            const float rm = xmax32(fmaxf(a_, b_));
            const unsigned va_ = (unsigned)(size_t)vb_;
            s16x4 la[4], ha[4], lb[4], hb[4];
            SB(); LDV(la, ha, 0); SB();
            if (t == 0 || __any(rm > THR)) {
                const float dl = (t == 0) ? rm : fmaxf(rm, 0.f), fsc = __builtin_amdgcn_exp2f(-dl);
                mhat += dl; lsum *= fsc;
#pragma unroll
                for (int i = 0; i < 16; ++i) { s0[i] -= dl; s1[i] -= dl; negm[i] = -mhat; }
                if (t != 0) {
#pragma unroll
                    for (int d = 0; d < 4; ++d)
#pragma unroll
                        for (int i = 0; i < 16; ++i) o[d][i] *= fsc; } }
            float ps = 0.f;
#pragma unroll
            for (int i = 0; i < 16; ++i) { s0[i] = __builtin_amdgcn_exp2f(s0[i]); s1[i] = __builtin_amdgcn_exp2f(s1[i]); ps += s0[i] + s1[i]; }
            lsum += ps;
            bf16x8 pf[4]; pf[0] = pack8(s0, 0); pf[1] = pack8(s0, 8); pf[2] = pack8(s1, 0); pf[3] = pack8(s1, 8);
            SB(); LDV(lb, hb, 1); LGKM(8); SB(); MMV(la, ha, 0); SB();
            LDV(la, ha, 2); LGKM(8); SB(); MMV(lb, hb, 1); SB();
            LDV(lb, hb, 3); LGKM(8); SB(); MMV(la, ha, 2); SB();
            LGKM(0); SB(); MMV(lb, hb, 3); SB();
        }
        if (t + 1 < NT) { if (t + 2 < NT) AT_WAIT_NEWEST(); else AT_WAITBAR(0); }
        sn2 = sc; sc = (sc == 2) ? 0 : sc + 1;
    }
    lsum = xsum32(lsum);
    const float inv = 1.0f / lsum;
    bf16_t* orow = O + qrow * pO + 8 * h;
#pragma unroll
    for (int d = 0; d < 4; ++d)
#pragma unroll
        for (int gp = 0; gp < 2; ++gp) { const int g = 2 * gp;
            const unsigned ax = cvtpk(o[d][4 * g] * inv, o[d][4 * g + 1] * inv), ay = cvtpk(o[d][4 * g + 2] * inv, o[d][4 * g + 3] * inv);
            const unsigned bx = cvtpk(o[d][4 * g + 4] * inv, o[d][4 * g + 5] * inv), by = cvtpk(o[d][4 * g + 6] * inv, o[d][4 * g + 7] * inv);
            const auto rx = __builtin_amdgcn_permlane32_swap(ax, bx, false, false); const auto ry = __builtin_amdgcn_permlane32_swap(ay, by, false, false);
            *(u32x4*)(orow + 32 * d + 16 * gp) = (u32x4){rx[0], ry[0], rx[1], ry[1]}; }
#undef AT_ISSUE
#undef AT_WAITBAR
#undef AT_WAIT_NEWEST
#undef SB
#undef LDK
#undef MMK
#undef LDV
#undef MMV
#undef TRR
#undef LGKM
}

DI void gmlp_unit(LAS char* lds, bf16_t* zU, const bf16_t* zV, const float* g_ln, const float* b_ln, const bf16_t* Wb, const float* b_sp, int R0, bool dummy = false) {
    constexpr int WP = 272, VP = 320;
    int tid_ = threadIdx.x; asm volatile("" : "+v"(tid_));
    const int tid = tid_, lane = tid & 63, wid = __builtin_amdgcn_readfirstlane(tid >> 6), r = lane & 31, h = lane >> 5;
    LAS char* Wl = lds; LAS char* Vn = lds + 128 * WP; LAS float* St = (LAS float*)(lds + 128 * WP + 128 * VP);
    __syncthreads();
    { u32x4 rw[16];
#pragma unroll
      for (int i = 0; i < 16; ++i) rw[i] = *(const u32x4*)(zV + (size_t)(R0 + wid * 16 + i) * 512 + lane * 8);
#pragma unroll
      for (int i = 0; i < 16; ++i) { const int s = wid * 16 + i; const u32x4 w = rw[i];
        const float v[8] = {bflo(w.x), bfhi(w.x), bflo(w.y), bfhi(w.y), bflo(w.z), bfhi(w.z), bflo(w.w), bfhi(w.w)};
        float a = 0.f, q = 0.f;
#pragma unroll
        for (int e = 0; e < 8; ++e) { a += v[e]; q += v[e] * v[e]; }
        a = wave_sum(a); q = wave_sum(q);
        const float mu = a * (1.0f / 512.0f), var = fmaxf(q * (1.0f / 512.0f) - mu * mu, 0.f);
        if (lane == 0) { St[2 * s] = mu; St[2 * s + 1] = __builtin_amdgcn_rsqf(var + EPSN); } } }
    const int q4 = (lane & 15) >> 2, p4 = lane & 3, blk = (lane >> 4) & 1, cb = wid & 3, tp = wid >> 2;
    const int lt = tid >> 4, lc8 = (tid & 15) * 8;
    u32x4 pw[4], pv[4]; f32x4 pg[2], pb[2];
#define GM_FETCH(g) do { _Pragma("unroll") for (int i = 0; i < 4; ++i) { pw[i] = *(const u32x4*)(Wb + (size_t)(g) * 16384 + (lt + 32 * i) * 128 + lc8); pv[i] = *(const u32x4*)(zV + (size_t)(R0 + lt + 32 * i) * 512 + (g) * 128 + lc8); } \
        pg[0] = *(const f32x4*)(g_ln + (g) * 128 + lc8); pg[1] = *(const f32x4*)(g_ln + (g) * 128 + lc8 + 4); pb[0] = *(const f32x4*)(b_ln + (g) * 128 + lc8); pb[1] = *(const f32x4*)(b_ln + (g) * 128 + lc8 + 4); } while (0)
    GM_FETCH(0);
#pragma unroll 1
    for (int g = 0; g < 4; ++g) {
        __syncthreads();
#pragma unroll
        for (int i = 0; i < 4; ++i) { const int s = lt + 32 * i;
            *(LAS u32x4*)(Wl + s * WP + lc8 * 2) = pw[i];
            const u32x4 w = pv[i]; float v[8] = {bflo(w.x), bfhi(w.x), bflo(w.y), bfhi(w.y), bflo(w.z), bfhi(w.z), bflo(w.w), bfhi(w.w)};
            const float mu = St[2 * s], rsd = St[2 * s + 1];
#pragma unroll
            for (int e = 0; e < 8; ++e) v[e] = (v[e] - mu) * rsd * pg[e >> 2][e & 3] + pb[e >> 2][e & 3];
            u32x4 o; o.x = cvtpk(v[0], v[1]); o.y = cvtpk(v[2], v[3]); o.z = cvtpk(v[4], v[5]); o.w = cvtpk(v[6], v[7]); *(LAS u32x4*)(Vn + s * VP + lc8 * 2) = o; }
        __syncthreads();
        if (g + 1 < 4) GM_FETCH(g + 1);
        u32x2 uw[2][4]; float bs[2];
#pragma unroll
        for (int tb = 0; tb < 2; ++tb) { const int t = 32 * (2 * tp + tb) + r; bs[tb] = b_sp[g * 128 + t]; const bf16_t* up = zU + (size_t)(R0 + t) * 512 + g * 128 + 32 * cb + 4 * h;
#pragma unroll
            for (int k = 0; k < 4; ++k) uw[tb][k] = *(const u32x2*)(up + 8 * k); }
        f32x16 a0, a1;
#pragma unroll
        for (int i = 0; i < 16; ++i) { a0[i] = 0.f; a1[i] = 0.f; }
        const int tb0 = 2 * tp, tb1 = 2 * tp + 1;
        const LAS char* vb_ = Vn + (8 * h + q4) * VP + cb * 64 + blk * 32 + p4 * 8;
        bf16x8 af[8], b0f[8], b1f[8];
#pragma unroll
        for (int ss = 0; ss < 8; ++ss) {
            if (16 * ss <= 32 * tb1 + 31) {
                const s16x4 lo = vtr(vb_ + (16 * ss) * VP), hi = vtr(vb_ + (16 * ss + 4) * VP);
                af[ss] = (bf16x8){lo[0], lo[1], lo[2], lo[3], hi[0], hi[1], hi[2], hi[3]};
                b1f[ss] = *(const LAS bf16x8*)(Wl + (32 * tb1 + r) * WP + (16 * ss + 8 * h) * 2);
                if (16 * ss <= 32 * tb0 + 31) b0f[ss] = *(const LAS bf16x8*)(Wl + (32 * tb0 + r) * WP + (16 * ss + 8 * h) * 2); } }
        __builtin_amdgcn_sched_barrier(0);
#pragma unroll
        for (int ss = 0; ss < 8; ++ss) {
            if (16 * ss <= 32 * tb1 + 31) { a1 = MFMA32(af[ss], b1f[ss], a1); if (16 * ss <= 32 * tb0 + 31) a0 = MFMA32(af[ss], b0f[ss], a0); } }
#pragma unroll
        for (int tb = 0; tb < 2; ++tb) { const int t = 32 * (2 * tp + tb) + r; bf16_t* up = zU + (size_t)(R0 + t) * 512 + g * 128 + 32 * cb + 4 * h;
#pragma unroll
            for (int k = 0; k < 4; ++k) { const u32x2 u2 = uw[tb][k]; u32x2 w; const f32x16& a = tb ? a1 : a0; const float b_ = bs[tb];
                w.x = cvtpk(bflo(u2.x) * (a[4 * k] + b_), bfhi(u2.x) * (a[4 * k + 1] + b_)); w.y = cvtpk(bflo(u2.y) * (a[4 * k + 2] + b_), bfhi(u2.y) * (a[4 * k + 3] + b_));
                if (dummy) w = u2;
                *(u32x2*)(up + 8 * k) = w; } }
    }
#undef GM_FETCH
}

DI int srccol(int mat, int n) {
    if (mat == 0) { if (n < 1408) return n; if (n < 1472) { const int c = n - 1408; return 1664 + (c & 1) * 32 + (c >> 1); } if (n < 1536) return -1; if (n < 1792) return 1408 + (n - 1536); return n - 64; }
    if (mat == 1) { if (n < 1024) return (n >> 7) * 192 + (n & 127); const int c = n - 1024, hh = c >> 6, cc = c & 63; return hh * 192 + 128 + (cc & 1) * 32 + (cc >> 1); }
    if (mat == 2) { if (n < 1024) return (n >> 7) * 256 + (n & 127); const int c = n - 1024; return (c >> 7) * 256 + 128 + (c & 127); }
    return n;
}
DI void transpose_item(const float* W, const float* gain, int K, int Ns, int Nd, int mat, bf16_t* WT, LAS float* scr, int item, int lane) {
    const int nblk = Nd / 32, kb = item / nblk, nb = item % nblk, k0 = 64 * kb, n0 = 32 * nb;
    const int sc = srccol(mat, n0 + (lane & 31));
#pragma unroll 8
    for (int i = 0; i < 32; ++i) { const int kk = 2 * i + (lane >> 5); float v = 0.f; if (sc >= 0) v = W[(size_t)(k0 + kk) * Ns + sc]; if (gain) v *= gain[k0 + kk]; scr[kk * 33 + (lane & 31)] = v; }
    asm volatile("s_waitcnt lgkmcnt(0)" ::: "memory");
    const int c = lane & 7;
#pragma unroll
    for (int j = 0; j < 4; ++j) { const int n = (lane >> 3) + 8 * j; const LAS float* s = scr + (8 * c) * 33 + n;
        u32x4 o; o.x = cvtpk(s[0 * 33], s[1 * 33]); o.y = cvtpk(s[2 * 33], s[3 * 33]); o.z = cvtpk(s[4 * 33], s[5 * 33]); o.w = cvtpk(s[6 * 33], s[7 * 33]);
        *(u32x4*)(WT + (size_t)(n0 + n) * K + k0 + 8 * c) = o; }
    asm volatile("s_waitcnt lgkmcnt(0)" ::: "memory");
}
template <int NR> DI void rows_to_bf16(const float* x0, bf16_t* o0, float* rstd0, int rstride, int nvalid, int lane) {
    f32x4 v[NR][4];
#pragma unroll
    for (int r = 0; r < NR; ++r) { const f32x4* xr = (const f32x4*)(x0 + (size_t)(r < nvalid ? r : 0) * rstride * 1024) + lane;
#pragma unroll
        for (int j = 0; j < 4; ++j) v[r][j] = xr[64 * j]; }
#pragma unroll
    for (int r = 0; r < NR; ++r) { if (r >= nvalid) break; float s = 0.f;
#pragma unroll
        for (int j = 0; j < 4; ++j) s += (v[r][j][0] * v[r][j][0] + v[r][j][1] * v[r][j][1]) + (v[r][j][2] * v[r][j][2] + v[r][j][3] * v[r][j][3]);
        s = wave_sum(s);
        u32x2* o8 = (u32x2*)(o0 + (size_t)r * rstride * 1024) + lane;
#pragma unroll
        for (int j = 0; j < 4; ++j) { u32x2 w; w.x = cvtpk(v[r][j][0], v[r][j][1]); w.y = cvtpk(v[r][j][2], v[r][j][3]); o8[64 * j] = w; }
        if (lane == 0) rstd0[(size_t)r * rstride] = __builtin_amdgcn_rsqf(s * (1.0f / 1024.0f) + EPSN); }
}


#define RLX_AGENT __ATOMIC_RELAXED, __HIP_MEMORY_SCOPE_AGENT
#define XB_TMO      128
#define XB_XCNT(j)  (256  + 64 * (j))
#define XB_XSUB(j)  (1280 + 64 * (j))
#define XB_XGEN(j)  (2304 + 64 * (j))
#define XB_TOP      3328
#define XB_TOPGEN   3392
#define XCD_BAR_WORDS 3456
#define XB_SPIN_CAP (1u << 18)

__device__ __forceinline__ unsigned xb_ld(unsigned* p)              { return __hip_atomic_load(p, __ATOMIC_RELAXED, __HIP_MEMORY_SCOPE_AGENT); }
__device__ __forceinline__ unsigned xb_add(unsigned* p, unsigned v) { return __hip_atomic_fetch_add(p, v, __ATOMIC_RELAXED, __HIP_MEMORY_SCOPE_AGENT); }
__device__ __forceinline__ unsigned xb_xcc_id() { return (unsigned)__builtin_amdgcn_s_getreg((3 << 11) | 20) & 0xFu; }
#define XB_SPIN(cond, bar) do { unsigned _sp = 0; while (cond) { __builtin_amdgcn_s_sleep(1); \
    if ((++_sp & 255u) == 0u) { if (xb_ld(&(bar)[XB_TMO])) break; if (_sp > XB_SPIN_CAP) { atomicAdd(&(bar)[XB_TMO], 1u); break; } } } } while (0)

struct XcdBarrier {
    unsigned* bar; unsigned x;
    volatile LAS unsigned* st;
};

__device__ __forceinline__ XcdBarrier xcd_barrier_post(unsigned* bar, volatile LAS unsigned* st) {
    XcdBarrier b; b.bar = bar; b.x = xb_xcc_id(); b.st = st;
    if (threadIdx.x == 0) (void)xb_add(&bar[XB_XCNT(b.x)], 1u);
    return b;
}
__device__ __forceinline__ void xcd_barrier_complete(unsigned* bar, unsigned x, unsigned& nloc, unsigned& nx) {
    const unsigned G = gridDim.x * gridDim.y * gridDim.z;
    unsigned sum, cnt, mine, sp = 0u;
    for (;;) {
        sum = 0u; cnt = 0u; mine = 0u;
#pragma unroll
        for (unsigned j = 0; j < 16; ++j) { const unsigned c = xb_ld(&bar[XB_XCNT(j)]); sum += c; cnt += (c > 0u) ? 1u : 0u; mine = (j == x) ? c : mine; }
        if (sum == G) break;
        __builtin_amdgcn_s_sleep(1);
        if ((++sp & 255u) == 0u) { if (xb_ld(&bar[XB_TMO])) break; if (sp > XB_SPIN_CAP) { atomicAdd(&bar[XB_TMO], 1u); break; } }
    }
    nloc = mine > 0u ? mine : 1u; nx = cnt > 0u ? cnt : 1u;
}

__device__ __forceinline__ void xcd_barrier(const XcdBarrier& b) {
    asm volatile("s_waitcnt vmcnt(0)" ::: "memory");
    __syncthreads();
    if (threadIdx.x == 0) {
        unsigned* bar = b.bar;
        __builtin_amdgcn_s_waitcnt(0);
        unsigned nloc = b.st[0], nx = b.st[1];
        if (nloc == 0u) { xcd_barrier_complete(bar, b.x, nloc, nx); b.st[0] = nloc; b.st[1] = nx; }
        const unsigned old = xb_add(&bar[XB_XSUB(b.x)], 1u);
        const unsigned gen = old / nloc;
        if (old + 1u == (gen + 1u) * nloc) {
            __builtin_amdgcn_fence(__ATOMIC_RELEASE, "agent");
            asm volatile("s_waitcnt vmcnt(0)" ::: "memory");
            const unsigned og = xb_add(&bar[XB_TOP], 1u);
            const unsigned tg = og / nx;
            if (og + 1u == (tg + 1u) * nx) xb_add(&bar[XB_TOPGEN], 1u);
            else XB_SPIN(xb_ld(&bar[XB_TOPGEN]) == tg, bar);
            __builtin_amdgcn_fence(__ATOMIC_ACQUIRE, "agent");
            xb_add(&bar[XB_XGEN(b.x)], 1u);
            asm volatile("s_waitcnt vmcnt(0)" ::: "memory");
        } else {
            XB_SPIN(xb_ld(&bar[XB_XGEN(b.x)]) == gen, bar);
            __builtin_amdgcn_fence(__ATOMIC_ACQUIRE, "agent");
            asm volatile("s_waitcnt vmcnt(0)" ::: "memory");
        }
    }
    __syncthreads();
}

struct Args { const float* in[28]; float* out; unsigned char* ws; };

typedef const __attribute__((address_space(4))) Args* KArgP;
DI Bag make_bag(KArgP kp, LAS unsigned char* lds) {
    unsigned char* ws = kp->ws; Bag b;
    b.x = kp->in[0]; b.g_qn = kp->in[9]; b.g_qp = kp->in[10]; b.g_kn = kp->in[11]; b.g_kp = kp->in[12]; b.g_mq = kp->in[19]; b.g_mk = kp->in[20];
    b.rstd_x = (float*)(ws + S_RSX); b.rstd_mem = (float*)(ws + S_RSM); b.ssq_cq = (float*)(ws + S_SSQCQ); b.ssq_ckv = (float*)(ws + S_SSQCKV); b.ssq2 = (float*)(ws + S_SSQ2); b.rope = (const float*)(ws + S_ROPE);
    b.zU = (bf16_t*)(ws + A_ZU); b.zV = (bf16_t*)(ws + A_ZV); b.zCQ = (bf16_t*)(ws + A_ZCQ); b.zCKV = (bf16_t*)(ws + A_ZCKV); b.zQM = (bf16_t*)(ws + A_ZQM); b.zG = (bf16_t*)(ws + A_ZG);
    b.q = (bf16_t*)(ws + A_Q); b.kv = (bf16_t*)kp->out; b.memkv = (bf16_t*)(ws + A_MEMKV); b.merged = (bf16_t*)kp->out; b.x1b = (bf16_t*)(ws + A_X1B); b.hdn = (bf16_t*)(ws + A_HDN);
    b.x1 = (float*)(ws + A_X1); b.out = kp->out; b.P = (LAS float*)(lds + P_OFF);
    return b;
}
#define WSP(off) ((bf16_t*)(kp->ws + (off)))
#define FRESH() asm volatile("" : "+s"(kp))
#ifndef PHM
#define PHM 0xff
#endif
#ifndef P2M
#define P2M 15
#endif
__global__ void __launch_bounds__(512) mega_fwd(Args a_unused) {
    extern __shared__ __attribute__((aligned(16))) unsigned char lds_raw[];
    cg::grid_group grid = cg::this_grid();
    LAS unsigned char* lds = (LAS unsigned char*)lds_raw;
    const int tid = threadIdx.x, lane = tid & 63, wave = __builtin_amdgcn_readfirstlane(tid >> 6), G = gridDim.x, bid = blockIdx.x;
    KArgP kp = (KArgP)__builtin_amdgcn_kernarg_segment_ptr();
    (void)a_unused;
    volatile LAS unsigned* bst = (volatile LAS unsigned*)(lds + P_OFF + 8192);
    if (tid == 0) { bst[0] = 0u; bst[1] = 0u; }
    if (bid == 0) { unsigned* bw = (unsigned*)(kp->ws + S_BAR); for (int i = tid; i < XCD_BAR_WORDS; i += 512) __hip_atomic_store(bw + i, 0u, RLX_AGENT); }
    __syncthreads();

#ifndef REP_P0
#define REP_P0 1
#endif
#ifndef REP_P6
#define REP_P6 1
#endif
#pragma unroll 1
    for (int rep0 = 0; rep0 < REP_P0; ++rep0) {
        FRESH();
        unsigned char* ws = kp->ws;
        LAS float* scr = (LAS float*)(lds + wave * 16384);
        const int gw = bid * 8 + wave, NGW = G * 8;
        constexpr int I0 = 16 * 168, I1 = 6 * 48, I2 = 4 * 64, I3 = 16 * 32, I4 = 8 * 32, I5 = 16 * 32, I6 = 8 * 32, I7 = 16 * 32, I8 = 16 * 128, I9 = 64 * 32;
        constexpr int NIT = I0 + I1 + I2 + I3 + I4 + I5 + I6 + I7;
        for (int it = gw; it < NIT; it += NGW) {
            int r = it;
            if (r < I0) { transpose_item(kp->in[4], kp->in[3], 1024, 5312, 5376, 0, WSP(W_IN), scr, r, lane); continue; } r -= I0;
            if (r < I1) { transpose_item(kp->in[6], kp->in[5], 384, 1536, 1536, 1, WSP(W_UQ), scr, r, lane); continue; } r -= I1;
            if (r < I2) { transpose_item(kp->in[8], kp->in[7], 256, 2048, 2048, 2, WSP(W_UKV), scr, r, lane); continue; } r -= I2;
            if (r < I3) { transpose_item(kp->in[18], kp->in[17], 1024, 1024, 1024, 3, WSP(W_MKV), scr, r, lane); continue; } r -= I3;
            if (r < I4) { transpose_item(kp->in[21], nullptr, 512, 1024, 1024, 3, WSP(W_OGM), scr, r, lane); continue; } r -= I4;
            if (r < I5) { transpose_item(kp->in[22], nullptr, 1024, 1024, 1024, 3, WSP(W_OMLA), scr, r, lane); continue; } r -= I5;
            if (r < I6) { transpose_item(kp->in[23], nullptr, 512, 1024, 1024, 3, WSP(W_OMEM), scr, r, lane); continue; } r -= I6;
            transpose_item(kp->in[24], nullptr, 1024, 1024, 1024, 3, WSP(W_WOUT), scr, r, lane);
        }
        { const float* x = kp->in[0]; bf16_t* xb = WSP(A_XB); float* rsx = (float*)(ws + S_RSX);
          for (int m = gw; m < T; m += 4 * NGW) rows_to_bf16<4>(x + (size_t)m * 1024, xb + (size_t)m * 1024, rsx + m, NGW, (T - 1 - m) / NGW + 1, lane); }
        { const float* mem = kp->in[1]; bf16_t* memb = WSP(A_MEMB); float* rsm = (float*)(ws + S_RSM);
          for (int m = gw; m < MEMT; m += 4 * NGW) rows_to_bf16<4>(mem + (size_t)m * 1024, memb + (size_t)m * 1024, rsm + m, NGW, (MEMT - 1 - m) / NGW + 1, lane); }
        { const float* wsp = kp->in[15]; bf16_t* wb = WSP(S_WSP);
          for (int idx = bid * 512 + tid; idx < 4 * 128 * 128 / 2; idx += G * 512) { const int e = idx * 2, t = (e >> 7) & 127, sc = e & 127; const f32x2_t w = *(const f32x2_t*)(wsp + e);
              *(unsigned*)(wb + e) = cvtpk(sc <= t ? w[0] : 0.f, sc + 1 <= t ? w[1] : 0.f); } }
        { float* z1 = (float*)(ws + S_SSQCQ); float* z2 = (float*)(ws + S_SSQCKV); float* z3 = (float*)(ws + S_SSQ2);
          for (int i = bid * 512 + tid; i < T; i += G * 512) { z1[i] = 0.f; z2[i] = 0.f; z3[i] = 0.f; } }
        float* rope = (float*)(ws + S_ROPE); const int* pos = (const int*)kp->in[2];
        for (int idx = bid * 512 + tid; idx < T * 32; idx += G * 512) { const int row = idx >> 5, p = idx & 31;
            const float invf = exp2f(-(float)(2 * p) * (13.287712379549449f / 64.0f)); const float ang = (float)pos[row] * invf;
            const double rev = (double)ang * 0.15915494309189535; const float fr_ = (float)(rev - __builtin_rint(rev));
            rope[2 * (size_t)idx] = __builtin_amdgcn_cosf(fr_); rope[2 * (size_t)idx + 1] = __builtin_amdgcn_sinf(fr_); }
    }
    grid.sync();
    const XcdBarrier xbar = xcd_barrier_post((unsigned*)(kp->ws + S_BAR), bst);
    if (PHM & 2) {
#ifndef REP_P1
#define REP_P1 1
#endif
#pragma unroll 1
        for (int r1 = 0; r1 < REP_P1; ++r1) { FRESH(); Bag b = make_bag(kp, lds);
          if (REP_P1 > 1 && r1 + 1 < REP_P1) { b.ssq_cq = (float*)(kp->ws + 48 * MiB); b.ssq_ckv = (float*)(kp->ws + 49 * MiB); }
          pg8::Gemm g{WSP(A_XB), WSP(W_IN), T, 5376, 1024, 1024}; pg8::StaticOrder S; S.init(T, 5376, G, bid); Epi<K_Z> E{b, 0};
          pg8::gemm_phase<Epi<K_Z>, pg8::StaticOrder, true, true, 1024, 1024>(lds, g, S, E); }
        { const int c2 = (bid + 128) % G;
          if (G <= 128 || c2 >= 128) { FRESH(); __syncthreads();
            LAS float* scr = (LAS float*)(lds + wave * 16384);
            const int rank = (G > 128) ? c2 - 128 : bid, nidle = (G > 128) ? G - 128 : G;
            constexpr int I8 = 16 * 128, I9 = 64 * 32;
            for (int it = rank * 8 + wave; it < I8 + I9; it += nidle * 8) {
                if (it < I8) transpose_item(kp->in[26], kp->in[25], 1024, 4096, 4096, 3, WSP(W_FF1), scr, it, lane);
                else transpose_item(kp->in[27], nullptr, 4096, 1024, 1024, 3, WSP(W_FF2), scr, it - I8, lane); }
            __syncthreads(); } }
        { FRESH(); const Bag b = make_bag(kp, lds);
          pg8::Gemm g2{WSP(A_MEMB), WSP(W_MKV), MEMT, 1024, 1024, 1024}; pg8::StaticOrder S2; S2.init(MEMT, 1024, G, (bid + 128) % G); Epi<K_MEMKV> E2{b, 0};
          pg8::gemm_phase<Epi<K_MEMKV>, pg8::StaticOrder, true, true, 1024, 1024>(lds, g2, S2, E2); }
    }
    xcd_barrier(xbar);
    if (PHM & 4) {
#pragma unroll 1
      for (int k2 = 0; k2 < 2; ++k2) { const int part = (bid & 1) ? 1 - k2 : k2;
      if (part == 0) {
#ifndef REP_P2G
#define REP_P2G 1
#endif
#ifndef REP_GM
#define REP_GM 1
#endif
#pragma unroll 1
        for (int rg = 0; rg < REP_P2G; ++rg) {
        if (P2M & 1) { FRESH(); const Bag b = make_bag(kp, lds);
          pg8::Gemm g{b.zCQ, WSP(W_UQ), T, 1536, 384, 512}; pg8::StaticOrder S; S.init(T, 1536, G, bid); Epi<K_Q> E{b, 0};
          pg8::gemm_phase<Epi<K_Q>, pg8::StaticOrder, true, true, 384, 512>(lds, g, S, E); }
        if (P2M & 2) { FRESH(); const Bag b = make_bag(kp, lds);
          pg8::Gemm g2{b.zCKV, WSP(W_UKV), T, 2048, 256, 256}; pg8::StaticOrder S2; S2.init(T, 2048, G, bid); Epi<K_KV> E2{b, 0};
          pg8::gemm_phase<Epi<K_KV>, pg8::StaticOrder, true, true, 256, 256>(lds, g2, S2, E2); }
        }
      } else {
        __syncthreads();
        if (P2M & 4) { FRESH();
#pragma unroll 1
          for (int u = bid; u < 512 * REP_GM; u += G) gmlp_unit((LAS char*)lds, WSP(A_ZU), WSP(A_ZV), kp->in[13], kp->in[14], WSP(S_WSP), kp->in[16], (u & 511) * 128, REP_GM > 1 && u < 512 * (REP_GM - 1)); }
        if (P2M & 8) { FRESH(); bf16_t* zQM = WSP(A_ZQM); const bf16_t* memkv = WSP(A_MEMKV);
#pragma unroll 1
          for (int u0 = bid; u0 < 1024; u0 += G) { int u = u0;
            if (G == 256) { const int L = (u0 >> 8) * 32 + (bid >> 3); u = ((L >> 3) * 8 + (bid & 7)) * 8 + (L & 7); }
            const int bb = u >> 5, hh = (u >> 3) & 3, qb = u & 7;
            bf16_t* Q = zQM + (size_t)bb * SEQ * 512 + hh * 128; const bf16_t* Kp = memkv + (size_t)bb * MEML * 1024 + hh * 128;
            attn_unit<128, false>((LAS char*)lds, Q, 512, nullptr, 0, Kp, 1024, nullptr, 0, Kp + 512, 1024, Q, 512, qb * 256, 4); } }
      }
      __syncthreads();
      }
    }
    xcd_barrier(xbar);
    if (PHM & 8) {
        FRESH(); bf16_t* q = WSP(A_Q); const bf16_t* kv = (const bf16_t*)kp->out; const bf16_t* zCQ = WSP(A_ZCQ);
#ifndef REP_P3
#define REP_P3 1
#endif
#pragma unroll 1
        for (int it = bid; it < 1024 * REP_P3; it += G) { int bh = it & 255, pr = (it >> 8) & 3;
            if (G == 256) { bh = ((bid & 7) + 8 * (bid >> 5)) + 64 * ((it >> 8) & 3); pr = (bid >> 3) & 3; }
            const int bb = bh >> 3, hh = bh & 7;
            bf16_t* Qa = q + (size_t)bb * SEQ * 1536 + hh * 128; const bf16_t* Qb = q + (size_t)bb * SEQ * 1536 + 1024 + hh * 64;
            const bf16_t* Ka = kv + (size_t)bb * SEQ * 2048 + hh * 128; const bf16_t* Kb = zCQ + (size_t)bb * SEQ * 512 + 384; const bf16_t* Vp = Ka + 1024;
            bf16_t* Op = Qa; int pO = 1536;
            if (REP_P3 > 1 && it < 1024 * (REP_P3 - 1)) { Op = WSP(A_ZV) + (size_t)bb * SEQ * 512 + (hh & 3) * 128; pO = 512; }
#pragma unroll 1
            for (int k = 0; k < 2; ++k) { const int qb = k ? 7 - pr : pr;
#if defined(P3ABL)
                if (REP_P3 > 1 && it < 1024 * (REP_P3 - 1)) attn_unit<192, true, P3ABL>((LAS char*)lds, Qa, 1536, Qb, 1536, Ka, 2048, Kb, 512, Vp, 2048, Op, pO, qb * 256, 4 * (qb + 1)); else
#endif
                attn_unit<192, true>((LAS char*)lds, Qa, 1536, Qb, 1536, Ka, 2048, Kb, 512, Vp, 2048, Op, pO, qb * 256, 4 * (qb + 1)); } }
    }
    xcd_barrier(xbar);
    if (PHM & 16) {
        pg8::StaticOrder S; S.init(T, 1024, G, bid);
#ifndef REP_P4
#define REP_P4 1
#endif
#pragma unroll 1
        for (int r4 = 0; r4 < REP_P4; ++r4) {
#pragma unroll 1
        for (int k = 0; k < 3; ++k) {
            const int brn = (k == 2) ? 2 : ((bid & 1) ? 1 - k : k), fl = brn | ((k > 0) << 8);
            FRESH(); const Bag b = make_bag(kp, lds); Epi<K_OUT> E{b, fl};
            if (brn == 1) { pg8::Gemm g{b.q, WSP(W_OMLA), T, 1024, 1024, 1536}; pg8::gemm_phase<Epi<K_OUT>, pg8::StaticOrder, true, true, 1024, 1536>(lds, g, S, E); }
            else { pg8::Gemm g{brn == 0 ? b.zU : b.zQM, brn == 0 ? WSP(W_OGM) : WSP(W_OMEM), T, 1024, 512, 512}; pg8::gemm_phase<Epi<K_OUT>, pg8::StaticOrder, true, true, 512, 512>(lds, g, S, E); }
        }
        }
    }
    xcd_barrier(xbar);
#ifndef REP_P5
#define REP_P5 1
#endif
#pragma unroll 1
    for (int r5 = 0; r5 < REP_P5; ++r5) { FRESH(); Bag b = make_bag(kp, lds); if (REP_P5 > 1 && r5 + 1 < REP_P5) b.ssq2 = (float*)(kp->ws + 48 * MiB); pg8::Gemm g{b.merged, WSP(W_WOUT), T, 1024, 1024, 1024}; pg8::StaticOrder S; S.init(T, 1024, G, bid); Epi<K_WOUT> E{b, 0}; pg8::gemm_phase<Epi<K_WOUT>, pg8::StaticOrder, true, true, 1024, 1024>(lds, g, S, E); }
    xcd_barrier(xbar);
#pragma unroll 1
    for (int rep6 = 0; rep6 < REP_P6; ++rep6) { FRESH(); const Bag b = make_bag(kp, lds); pg8::Gemm g{b.x1b, WSP(W_FF1), T, 4096, 1024, 1024}; pg8::StaticOrder S; S.init(T, 4096, G, bid); Epi<K_FF1> E{b, 0}; pg8::gemm_phase<Epi<K_FF1>, pg8::StaticOrder, true, true, 1024, 1024>(lds, g, S, E); }
    xcd_barrier(xbar);
#ifndef REP_P7
#define REP_P7 1
#endif
#pragma unroll 1
    for (int r7 = 0; r7 < REP_P7; ++r7) { FRESH(); const Bag b = make_bag(kp, lds); pg8::Gemm g{b.hdn, WSP(W_FF2), T, 1024, 4096, 4096}; pg8::StaticOrder S; S.init(T, 1024, G, bid); Epi<K_FF2> E{b, 0}; pg8::gemm_phase<Epi<K_FF2>, pg8::StaticOrder, true, true, 4096, 4096>(lds, g, S, E); }
}

extern "C" void kernel_launch(void* const* d_in, const int* in_sizes, int n_in, void* d_out, int out_size, void* d_ws, size_t ws_size, hipStream_t stream) {
    static int grid_blocks = 0;
    if (grid_blocks == 0) {
        if (n_in != 28 || ws_size < WS_NEED) { fprintf(stderr, "kernel_launch: need 28 inputs and %zu bytes of workspace (got %d, %zu)\n", (size_t)WS_NEED, n_in, ws_size); grid_blocks = -1; return; }
        int dev = 0, cus = 0, per_cu = 0;
        hipGetDevice(&dev); hipDeviceGetAttribute(&cus, hipDeviceAttributeMultiprocessorCount, dev);
        if (hipFuncSetAttribute((const void*)mega_fwd, hipFuncAttributeMaxDynamicSharedMemorySize, LDS_BYTES) != hipSuccess) { fprintf(stderr, "kernel_launch: hipFuncSetAttribute failed\n"); grid_blocks = -1; return; }
        if (hipOccupancyMaxActiveBlocksPerMultiprocessor(&per_cu, (const void*)mega_fwd, 512, LDS_BYTES) != hipSuccess || per_cu < 1) { fprintf(stderr, "kernel_launch: occupancy query gave %d\n", per_cu); per_cu = 1; }
        (void)hipGetLastError();
        grid_blocks = cus * (per_cu > 1 ? 1 : per_cu);
    }
    if (grid_blocks < 0) return;
    Args a{};
    for (int i = 0; i < 28; ++i) a.in[i] = (const float*)d_in[i];
    a.out = (float*)d_out; a.ws = (unsigned char*)d_ws;
    void* args[] = {&a};
    hipError_t e = hipLaunchCooperativeKernel((const void*)mega_fwd, dim3(grid_blocks), dim3(512), args, LDS_BYTES, stream);
    if (e != hipSuccess) fprintf(stderr, "cooperative launch failed: %s (grid %d)\n", hipGetErrorString(e), grid_blocks);
}
```

```cpp
#include <hip/hip_runtime.h>
#include <hip/hip_cooperative_groups.h>
#include <cstdio>
#include <cstdint>
namespace cg = cooperative_groups;
namespace pg8 {
#define PG8_LAS __attribute__((address_space(3)))
typedef unsigned short bf16_t;
typedef short bf16x8 __attribute__((ext_vector_type(8)));
typedef float f32x4 __attribute__((ext_vector_type(4)));
typedef unsigned u32x4 __attribute__((ext_vector_type(4)));
constexpr int BM = 256, BK = 64, HALF = 128, HTB = HALF * BK * 2  , STAGE_BYTES = 8 * HTB, NXCD = 8, WGM = 8;

__host__ __device__ __forceinline__ int lds_byte(int r, int c) { const int st = (r >> 4) * 2 + (c >> 5), rr = r & 15, cc = c & 31, ob = rr * 64 + cc * 2; return st * 1024 + (ob ^ (((ob >> 9) & 1) << 5)); }
__host__ __device__ __forceinline__ void stage_rc(int b, int& R, int& C) { const int st = b / 1024, sb = b % 1024, swz = sb ^ (((sb >> 9) & 1) << 5); R = (st >> 1) * 16 + swz / 64; C = (st & 1) * 32 + (swz % 64) / 2; }
__host__ __device__ __forceinline__ int perm32(int rho) { const int n = rho >> 4, i = rho & 15; return 8 * (i >> 2) + 4 * n + (i & 3); }

struct Unit { int pm, pn; };
struct Gemm { const bf16_t* A; const bf16_t* Bt; int M, N, K, lda; };

struct StaticOrder {
    int nM, nN, nwg, G, c;
    __host__ __device__ void init(int M, int N, int G_, int c_) { nM = M / BM; nN = N / BM; nwg = nM * nN; G = G_; c = c_; }
    __host__ __device__ bool next(int i, Unit& u) const {
        const long L = (long)i * G + c; if (L >= nwg) return false;
        int wgid = (int)L; { const int q = nwg / NXCD, r = nwg % NXCD, xcd = wgid % NXCD, off = wgid / NXCD; wgid = (xcd < r ? xcd * (q + 1) : r * (q + 1) + (xcd - r) * q) + off; }
        const int nig = WGM * nN, gid = wgid / nig, fm = gid * WGM, gsz = (nM - fm) < WGM ? (nM - fm) : WGM;
        u.pm = fm + ((wgid % nig) % gsz); u.pn = (wgid % nig) / gsz; return true;
    }
    __device__ __forceinline__ void a_ready(const Unit&) const {}
    __device__ __forceinline__ void done(const Unit&) const {}
};

template <class Epi, class Sched, bool ALIGN_EPI = false, bool SP2 = false, int KC = 0, int LDAC = 0>
__device__ __forceinline__ void gemm_phase(PG8_LAS unsigned char* lds, const Gemm g, const Sched& S, const Epi& E) {
    int tid_ = threadIdx.x; asm volatile("" : "+v"(tid_));
    const int tid = tid_, wid = __builtin_amdgcn_readfirstlane(tid >> 6), lane = tid & 63, wr = wid >> 2, wc = wid & 3, fr = lane & 15, fq = lane >> 4;
    const int K = KC ? KC : g.K, nt = K / BK, lda_ = LDAC ? LDAC : g.lda;
    unsigned voffA[2], voffB[2];
#pragma unroll
    for (int i = 0; i < 2; ++i) { int R, C; stage_rc(tid * 16 + i * 8192, R, C); const int Rb = Epi::PERM ? ((R & ~31) + perm32(R & 31)) : R;
        voffA[i] = (unsigned)(R * lda_ + C) * 2u; voffB[i] = (unsigned)(Rb * K + C) * 2u; }
    const size_t kstep = (size_t)(BK * 2);
    const size_t hstepA = (size_t)HALF * lda_ * 2, hstepB = (size_t)HALF * K * 2;
    const size_t tstepA = 2 * hstepA, tstepB = 2 * hstepB;
    const unsigned ldsw = (unsigned)wid * 1024u;
    const int aoff = lds_byte(wr * 64 + fr, fq * 8), boff = lds_byte(wc * 32 + fr, fq * 8);
#define PG8_SA(b, h) (((b) * 2 + (h)) * HTB)
#define PG8_SB(b, h) ((4 + (b) * 2 + (h)) * HTB)
#define PG8_STAGE(bufoff, gbase, voff) do { _Pragma("unroll") for (int _i = 0; _i < 2; ++_i) \
        __builtin_amdgcn_global_load_lds((const unsigned*)((const char*)(gbase) + (voff)[_i]), (PG8_LAS unsigned*)(lds + (bufoff) + ldsw + _i * 8192), 16, 0, 0); } while (0)
#define PG8_LDA(dst, b, h) do { _Pragma("unroll") for (int m = 0; m < 4; ++m) _Pragma("unroll") for (int k = 0; k < 2; ++k) dst[m][k] = *(const PG8_LAS bf16x8*)(lds + PG8_SA(b, h) + aoff + m * 2048 + k * 1024); } while (0)
#define PG8_LDB(dst, b, h) do { _Pragma("unroll") for (int n = 0; n < 2; ++n) _Pragma("unroll") for (int k = 0; k < 2; ++k) dst[n][k] = *(const PG8_LAS bf16x8*)(lds + PG8_SB(b, h) + boff + n * 2048 + k * 1024); } while (0)
#define PG8_MMA(ai, bj, At, Bt) do { __builtin_amdgcn_s_setprio(1); _Pragma("unroll") for (int m = 0; m < 4; ++m) _Pragma("unroll") for (int n = 0; n < 2; ++n) _Pragma("unroll") for (int k = 0; k < 2; ++k) \
        acc[ai][bj][m][n] = __builtin_amdgcn_mfma_f32_16x16x32_bf16(Bt[n][k], At[m][k], acc[ai][bj][m][n], 0, 0, 0); __builtin_amdgcn_s_setprio(0); } while (0)
#define PG8_WAIT_V(n) asm volatile("s_waitcnt vmcnt(" #n ")" ::: "memory")
#define PG8_WAIT_L(n) asm volatile("s_waitcnt lgkmcnt(" #n ")" ::: "memory")
#define PG8_BAR __builtin_amdgcn_s_barrier()
#define PG8_SCHED __builtin_amdgcn_sched_barrier(0)
    Unit cur, nxt; int ui = 0;
    if (!S.next(0, cur)) return;
    f32x4 acc[2][2][4][2];
#pragma unroll
    for (int a = 0; a < 2; ++a)
#pragma unroll
        for (int b = 0; b < 2; ++b)
#pragma unroll
            for (int m = 0; m < 4; ++m)
#pragma unroll
                for (int n = 0; n < 2; ++n) acc[a][b][m][n] = (f32x4){0.f, 0.f, 0.f, 0.f};
    bf16x8 At[4][2], B0[2][2], B1[2][2];
    const char* cA = (const char*)g.A + (size_t)cur.pm * tstepA; const char* cB = (const char*)g.Bt + (size_t)cur.pn * tstepB;
    S.a_ready(cur);
    if constexpr (SP2) {
        PG8_STAGE(PG8_SB(0, 0), cB, voffB); PG8_STAGE(PG8_SB(0, 1), cB + hstepB, voffB); PG8_STAGE(PG8_SA(0, 0), cA, voffA); PG8_STAGE(PG8_SA(0, 1), cA + hstepA, voffA);
        if (wr == 1) PG8_BAR;
        PG8_WAIT_V(2); PG8_BAR;
        PG8_STAGE(PG8_SB(1, 0), cB + kstep, voffB); PG8_STAGE(PG8_SA(1, 0), cA + kstep, voffA); PG8_STAGE(PG8_SB(1, 1), cB + hstepB + kstep, voffB);
        PG8_WAIT_V(6); PG8_BAR;
    } else {
        PG8_STAGE(PG8_SB(0, 0), cB, voffB); PG8_STAGE(PG8_SA(0, 0), cA, voffA); PG8_STAGE(PG8_SB(0, 1), cB + hstepB, voffB); PG8_STAGE(PG8_SA(0, 1), cA + hstepA, voffA);
        if (wr == 1) PG8_BAR;
        PG8_WAIT_V(4); PG8_BAR;
        PG8_STAGE(PG8_SB(1, 0), cB + kstep, voffB); PG8_STAGE(PG8_SA(1, 0), cA + kstep, voffA); PG8_STAGE(PG8_SB(1, 1), cB + hstepB + kstep, voffB);
        PG8_WAIT_V(6); PG8_BAR;
    }
    for (;;) {
        const bool has_next = S.next(ui + 1, nxt);
        const char* nA = has_next ? (const char*)g.A + (size_t)nxt.pm * tstepA : cA; const char* nB = has_next ? (const char*)g.Bt + (size_t)nxt.pn * tstepB : cB;
#pragma unroll 1
        for (int t = 0; t < nt; t += 2) {
            const bool last = (t == nt - 2);
            const char* a1 = cA + (size_t)(t + 1) * kstep;
            const char* a2 = last ? nA : cA + (size_t)(t + 2) * kstep; const char* b2 = last ? nB : cB + (size_t)(t + 2) * kstep;
            const char* a3 = a2 + kstep; const char* b3 = b2 + kstep;
            if (last && has_next) S.a_ready(nxt);
            if constexpr (SP2) {
            PG8_LDB(B0, 0, 0); PG8_LDB(B1, 0, 1); PG8_SCHED; PG8_LDA(At, 0, 0); PG8_STAGE(PG8_SA(1, 1), a1 + hstepA, voffA);
            PG8_WAIT_V(8); PG8_WAIT_L(0); PG8_BAR; PG8_MMA(0, 0, At, B0); PG8_MMA(0, 1, At, B1); PG8_BAR; PG8_SCHED;
            PG8_LDA(At, 0, 1); PG8_STAGE(PG8_SB(0, 0), b2, voffB); PG8_STAGE(PG8_SB(0, 1), b2 + hstepB, voffB); PG8_STAGE(PG8_SA(0, 0), a2, voffA);
            PG8_WAIT_V(8); PG8_WAIT_L(0); PG8_BAR; PG8_MMA(1, 0, At, B0); PG8_MMA(1, 1, At, B1); PG8_BAR; PG8_SCHED;
            PG8_LDB(B0, 1, 0); PG8_LDB(B1, 1, 1); PG8_SCHED; PG8_LDA(At, 1, 0); PG8_STAGE(PG8_SA(0, 1), a2 + hstepA, voffA);
            PG8_WAIT_V(8); PG8_WAIT_L(0); PG8_BAR; PG8_MMA(0, 0, At, B0); PG8_MMA(0, 1, At, B1); PG8_BAR; PG8_SCHED;
            PG8_LDA(At, 1, 1); PG8_STAGE(PG8_SB(1, 0), b3, voffB); PG8_STAGE(PG8_SB(1, 1), b3 + hstepB, voffB); PG8_STAGE(PG8_SA(1, 0), a3, voffA);
            PG8_WAIT_V(8); PG8_WAIT_L(0); PG8_BAR; PG8_MMA(1, 0, At, B0); PG8_MMA(1, 1, At, B1); PG8_BAR; PG8_SCHED;
            } else {
            PG8_LDB(B0, 0, 0); PG8_SCHED; PG8_LDA(At, 0, 0); PG8_STAGE(PG8_SA(1, 1), a1 + hstepA, voffA);
            PG8_WAIT_L(8); PG8_BAR; PG8_WAIT_L(0); PG8_MMA(0, 0, At, B0); PG8_BAR; PG8_SCHED;
            PG8_LDB(B1, 0, 1); PG8_STAGE(PG8_SB(0, 0), b2, voffB);
            PG8_BAR; PG8_WAIT_L(0); PG8_MMA(0, 1, At, B1); PG8_BAR;
            PG8_LDA(At, 0, 1); PG8_STAGE(PG8_SA(0, 0), a2, voffA);
            PG8_BAR; PG8_WAIT_L(0); PG8_MMA(1, 0, At, B0); PG8_BAR; PG8_SCHED;
            PG8_STAGE(PG8_SB(0, 1), b2 + hstepB, voffB);
            PG8_WAIT_V(6); PG8_BAR; PG8_MMA(1, 1, At, B1); PG8_BAR;
            PG8_LDB(B0, 1, 0); PG8_SCHED; PG8_LDA(At, 1, 0); PG8_STAGE(PG8_SA(0, 1), a2 + hstepA, voffA);
            PG8_WAIT_L(8); PG8_BAR; PG8_WAIT_L(0); PG8_MMA(0, 0, At, B0); PG8_BAR; PG8_SCHED;
            PG8_LDB(B1, 1, 1); PG8_STAGE(PG8_SB(1, 0), b3, voffB);
            PG8_BAR; PG8_WAIT_L(0); PG8_MMA(0, 1, At, B1); PG8_BAR;
            PG8_LDA(At, 1, 1); PG8_STAGE(PG8_SA(1, 0), a3, voffA);
            PG8_BAR; PG8_WAIT_L(0); PG8_MMA(1, 0, At, B0); PG8_BAR; PG8_SCHED;
            PG8_STAGE(PG8_SB(1, 1), b3 + hstepB, voffB);
            PG8_WAIT_V(6); PG8_BAR; PG8_MMA(1, 1, At, B1); PG8_BAR;
            }
        }
        if constexpr (ALIGN_EPI) { if (wr == 0) PG8_BAR; }
        if constexpr (!Epi::AFTER_DRAIN) { E(acc, cur, wr, wc, fr, fq); S.done(cur); }
        if (!has_next) break;
#pragma unroll
        for (int a = 0; a < 2; ++a)
#pragma unroll
            for (int b = 0; b < 2; ++b)
#pragma unroll
                for (int m = 0; m < 4; ++m)
#pragma unroll
                    for (int n = 0; n < 2; ++n) acc[a][b][m][n] = (f32x4){0.f, 0.f, 0.f, 0.f};
        cur = nxt; cA = nA; cB = nB; ++ui;
        if constexpr (ALIGN_EPI) { if (wr == 1) PG8_BAR; }
    }
    PG8_WAIT_V(0);
    if constexpr (!ALIGN_EPI) { if (wr == 0) PG8_BAR; }
    PG8_BAR;
    if constexpr (Epi::AFTER_DRAIN) { E.fused(acc, cur, wr, wc, fr, fq, lds, wid, lane); S.done(cur); }
#undef PG8_SA
#undef PG8_SB
#undef PG8_STAGE
#undef PG8_LDA
#undef PG8_LDB
#undef PG8_MMA
#undef PG8_WAIT_V
#undef PG8_WAIT_L
#undef PG8_BAR
#undef PG8_SCHED
}
}

#define LAS __attribute__((address_space(3)))
#define DI __device__ __forceinline__
using pg8::bf16_t; using pg8::bf16x8; using pg8::f32x4; using pg8::u32x4;
typedef short s16x4 __attribute__((ext_vector_type(4)));
typedef short v4i16_t __attribute__((ext_vector_type(4)));
typedef float f32x16 __attribute__((ext_vector_type(16)));
typedef float f32x2_t __attribute__((ext_vector_type(2)));
typedef __bf16 bf16x2_t __attribute__((ext_vector_type(2)));
typedef unsigned u32x2 __attribute__((ext_vector_type(2)));

constexpr int T = 65536, SEQ = 2048, NB = 32, DM = 1024, MEMT = 8192, MEML = 256;
constexpr float EPSN = 1e-6f, LOG2E = 1.4426950408889634f;
constexpr size_t MiB = 1u << 20;
constexpr size_t W_IN = 0, W_UQ = 11 * MiB, W_UKV = 13 * MiB, W_MKV = 14 * MiB, W_OGM = 16 * MiB, W_OMLA = 17 * MiB, W_OMEM = 19 * MiB, W_WOUT = 20 * MiB, W_FF1 = 22 * MiB, W_FF2 = 30 * MiB;
constexpr size_t S_WSP = 39 * MiB + 512 * 1024;
constexpr size_t S_BAR = 39 * MiB;
constexpr size_t S_RSX = 40 * MiB, S_RSM = S_RSX + 256 * 1024, S_SSQCQ = 41 * MiB, S_SSQCKV = 44 * MiB, S_SSQ2 = 46 * MiB, S_ROPE = 50 * MiB;
constexpr size_t A_ZU = 72 * MiB, A_ZV = 136 * MiB, A_X1B = 72 * MiB, A_MEMB = 200 * MiB, A_MEMKV = 216 * MiB, A_Q = 232 * MiB, A_XB = 232 * MiB;
constexpr size_t A_ZCQ = 424 * MiB, A_ZCKV = 488 * MiB, A_ZQM = 520 * MiB, A_ZG = 584 * MiB, A_HDN = 200 * MiB, A_X1 = 712 * MiB, WS_NEED = 968 * MiB;
constexpr int RING_BYTES = 131072, P_OFF = RING_BYTES, LDS_BYTES = 147456;

DI unsigned cvtpk(float lo, float hi) { f32x2_t v = {lo, hi}; bf16x2_t b = __builtin_convertvector(v, bf16x2_t); return __builtin_bit_cast(unsigned, b); }
DI float bflo(unsigned w) { return __uint_as_float(w << 16); }
DI float bfhi(unsigned w) { return __uint_as_float(w & 0xffff0000u); }
DI float wave_sum(float v) {
    v += __builtin_bit_cast(float, __builtin_amdgcn_update_dpp(0, __builtin_bit_cast(int, v), 0x121, 0xf, 0xf, false));
    v += __builtin_bit_cast(float, __builtin_amdgcn_update_dpp(0, __builtin_bit_cast(int, v), 0x122, 0xf, 0xf, false));
    v += __builtin_bit_cast(float, __builtin_amdgcn_update_dpp(0, __builtin_bit_cast(int, v), 0x124, 0xf, 0xf, false));
    v += __builtin_bit_cast(float, __builtin_amdgcn_update_dpp(0, __builtin_bit_cast(int, v), 0x128, 0xf, 0xf, false));
    { const auto r = __builtin_amdgcn_permlane16_swap(__float_as_uint(v), __float_as_uint(v), false, false); v = __uint_as_float(r[0]) + __uint_as_float(r[1]); }
    { const auto r = __builtin_amdgcn_permlane32_swap(__float_as_uint(v), __float_as_uint(v), false, false); v = __uint_as_float(r[0]) + __uint_as_float(r[1]); }
    return v;
}
DI float xsum16(float s) { const auto r = __builtin_amdgcn_permlane16_swap(__float_as_uint(s), __float_as_uint(s), false, false); return __uint_as_float(r[0]) + __uint_as_float(r[1]); }
DI float xsum32(float s) { const auto r = __builtin_amdgcn_permlane32_swap(__float_as_uint(s), __float_as_uint(s), false, false); return __uint_as_float(r[0]) + __uint_as_float(r[1]); }
DI float xmax32(float s) { const auto r = __builtin_amdgcn_permlane32_swap(__float_as_uint(s), __float_as_uint(s), false, false); return fmaxf(__uint_as_float(r[0]), __uint_as_float(r[1])); }
DI float gelu_t(float x) { const float t = x + 0.044715f * x * x * x; return x * __builtin_amdgcn_rcpf(1.0f + __builtin_amdgcn_exp2f(-2.3022082f * t)); }
DI float sigm(float x) { return __builtin_amdgcn_rcpf(1.0f + __builtin_amdgcn_exp2f(-LOG2E * x)); }
DI void st8(bf16_t* p, const float (&v)[8]) { u32x4 w; w.x = cvtpk(v[0], v[1]); w.y = cvtpk(v[2], v[3]); w.z = cvtpk(v[4], v[5]); w.w = cvtpk(v[6], v[7]); *(u32x4*)p = w; }
DI void ld8f(const float* p, float (&v)[8]) { const f32x4 a = *(const f32x4*)p, b = *(const f32x4*)(p + 4); v[0] = a[0]; v[1] = a[1]; v[2] = a[2]; v[3] = a[3]; v[4] = b[0]; v[5] = b[1]; v[6] = b[2]; v[7] = b[3]; }
DI void ld8b(const bf16_t* p, float (&v)[8]) { const u32x4 w = *(const u32x4*)p; v[0] = bflo(w.x); v[1] = bfhi(w.x); v[2] = bflo(w.y); v[3] = bfhi(w.y); v[4] = bflo(w.z); v[5] = bfhi(w.z); v[6] = bflo(w.w); v[7] = bfhi(w.w); }
#define EPI_BAR() do { asm volatile("s_waitcnt lgkmcnt(0)" ::: "memory"); __builtin_amdgcn_s_barrier(); asm volatile("" ::: "memory"); } while (0)

struct Bag {
    const float *x, *g_qn, *g_qp, *g_kn, *g_kp, *g_mq, *g_mk;
    float *rstd_x, *rstd_mem, *ssq_cq, *ssq_ckv, *ssq2; const float* rope;
    bf16_t *zU, *zV, *zCQ, *zCKV, *zQM, *zG, *q, *kv, *memkv, *merged, *x1b, *hdn;
    float *x1, *out;
    LAS float* P;
};
typedef f32x4 AccT[2][2][4][2];
#define ACC8(v, ai, bj, m, s) do { const f32x4 a_ = acc[ai][bj][m][0] * (s), b_ = acc[ai][bj][m][1] * (s); v[0] = a_[0]; v[1] = a_[1]; v[2] = a_[2]; v[3] = a_[3]; v[4] = b_[0]; v[5] = b_[1]; v[6] = b_[2]; v[7] = b_[3]; } while (0)
DI float ssq8(const float (&v)[8]) { float s = (v[0] * v[0] + v[1] * v[1]) + (v[2] * v[2] + v[3] * v[3]) + (v[4] * v[4] + v[5] * v[5]) + (v[6] * v[6] + v[7] * v[7]); s = xsum16(s); s = xsum32(s); return s; }

template <int NS> DI void row_scales(const float* rsp, float inv, int grow0, float (&rs)[8]) {
#pragma unroll
    for (int it = 0; it < 8; ++it) rs[it] = rsp[grow0 + (it >> 2) * 128 + (it & 3) * 16];
    if (NS != 0) {
#pragma unroll
        for (int it = 0; it < 8; ++it) rs[it] = __builtin_amdgcn_rsqf(rs[it] * inv + EPSN); }
}
template <int GS, bool ROPE, int NS>
DI void headnorm(const AccT& acc, const float* rsp, float rs_inv, const float* gain, float oscale, bf16_t* dst, int ld, int grow0, int bj_lo,
                 int wr, int wc, int fr, int fq, LAS float* P, const float* rope) {
    const int rowl0 = wr * 64 + fr, cl0 = wc * 32 + 8 * fq, ch = cl0 & (GS - 1);
#pragma unroll
    for (int ai = 0; ai < 2; ++ai)
#pragma unroll
        for (int m = 0; m < 4; ++m)
#pragma unroll
            for (int bj = 0; bj < 2; ++bj) { if (bj < bj_lo) continue; float v[8]; ACC8(v, ai, bj, m, 1.0f); const float s = ssq8(v);
                if (fq == 0) P[(ai * 128 + m * 16 + rowl0) * 8 + bj * 4 + wc] = s; }
    EPI_BAR();
    float rs[8]; row_scales<NS>(rsp, rs_inv, grow0, rs);
    float g8[8];
    if (ROPE) { const int p0 = ch >> 1;
#pragma unroll
        for (int e = 0; e < 8; ++e) g8[e] = gain[(e & 1) * 32 + p0 + (e >> 1)] * oscale;
    } else { ld8f(gain + ch, g8);
#pragma unroll
        for (int e = 0; e < 8; ++e) g8[e] *= oscale; }
    f32x4 cs[4][2];
#define CS_LOAD(itn) do { const size_t gn_ = (size_t)(grow0 + ((itn) >> 2) * 128 + ((itn) & 3) * 16); cs[(itn) & 3][0] = *(const f32x4*)(rope + gn_ * 64 + ch); cs[(itn) & 3][1] = *(const f32x4*)(rope + gn_ * 64 + ch + 4); } while (0)
    if (ROPE) { CS_LOAD(0); CS_LOAD(1); CS_LOAD(2); CS_LOAD(3); }
#pragma unroll
    for (int it = 0; it < 8; ++it) { const int ai = it >> 2, m = it & 3, rl = ai * 128 + m * 16 + rowl0; const size_t grow = (size_t)(grow0 + ai * 128 + m * 16);
        __builtin_amdgcn_sched_barrier(0);
#pragma unroll
        for (int bj = 0; bj < 2; ++bj) { if (bj < bj_lo) continue;
            const f32x4 p4 = *(const LAS f32x4*)(P + rl * 8 + bj * 4);
            const float tot = ((GS == 128) ? (p4[0] + p4[1]) + (p4[2] + p4[3]) : (wc < 2 ? p4[0] + p4[1] : p4[2] + p4[3])) * rs[it] * rs[it];
            const float r = __builtin_amdgcn_rsqf(tot * (1.0f / GS) + EPSN) * rs[it];
            float v[8]; ACC8(v, ai, bj, m, r);
#pragma unroll
            for (int e = 0; e < 8; ++e) v[e] *= g8[e];
            if (ROPE) { const f32x4 c0 = cs[it & 3][0], c1 = cs[it & 3][1]; const float cv[8] = {c0[0], c0[1], c0[2], c0[3], c1[0], c1[1], c1[2], c1[3]};
#pragma unroll
                for (int k = 0; k < 4; ++k) { const float a = v[2 * k], b = v[2 * k + 1], c = cv[2 * k], sn = cv[2 * k + 1]; v[2 * k] = a * c - b * sn; v[2 * k + 1] = b * c + a * sn; } }
            st8(dst + grow * ld + bj * 128 + cl0, v); }
        __builtin_amdgcn_sched_barrier(0); if (ROPE && it + 4 < 8) CS_LOAD(it + 4); __builtin_amdgcn_sched_barrier(0); }
#undef CS_LOAD
}

enum { K_Z = 0, K_MEMKV, K_Q, K_KV, K_OUT, K_WOUT, K_FF1, K_FF2 };
template <int KIND> struct Epi {
    static constexpr bool PERM = true, AFTER_DRAIN = false;
    Bag b; int br;
    DI void operator()(const AccT& acc, const pg8::Unit& u, int wr, int wc, int fr_in, int fq_in) const {
        int ln_; asm volatile("v_mbcnt_lo_u32_b32 %0, -1, 0\n\tv_mbcnt_hi_u32_b32 %0, -1, %0" : "=v"(ln_));
        const int fr = ln_ & 15, fq = ln_ >> 4; (void)fr_in; (void)fq_in;
        const int grow0 = u.pm * 256 + wr * 64 + fr, cl0 = wc * 32 + 8 * fq, pn = u.pn, tc0 = pn * 256 + cl0;
#define IT_AI (it >> 2)
#define IT_M (it & 3)
#define IT_ROW ((size_t)(grow0 + (it >> 2) * 128 + (it & 3) * 16))
#define ITLOOP _Pragma("unroll") for (int it = 0; it < 8; ++it)
#define BJLOOP _Pragma("unroll") for (int bj = 0; bj < 2; ++bj)
#define SBE() __builtin_amdgcn_sched_barrier(0)
        if (KIND == K_Z) {
            float rs[8]; row_scales<0>(b.rstd_x, 0.f, grow0, rs);
            if (pn < 4) { bf16_t* dst = (pn < 2 ? b.zU : b.zV) + (pn & 1) * 256 + cl0;
                ITLOOP { BJLOOP { float v[8]; ACC8(v, IT_AI, bj, IT_M, rs[it]);
#pragma unroll
                    for (int e = 0; e < 8; ++e) v[e] = gelu_t(v[e]);
                    st8(dst + IT_ROW * 512 + bj * 128, v); } SBE(); }
            } else if (pn == 4 || pn == 6) { bf16_t* dst = (pn == 4 ? b.zCQ : b.zCKV) + cl0; const int ld = (pn == 4) ? 512 : 256; float* sq = (pn == 4) ? b.ssq_cq : b.ssq_ckv;
                ITLOOP { float s = 0.f; BJLOOP { float v[8]; ACC8(v, IT_AI, bj, IT_M, rs[it]); s += ssq8(v); st8(dst + IT_ROW * ld + bj * 128, v); } if (fq == 0) __hip_atomic_fetch_add(sq + IT_ROW, s, __ATOMIC_RELAXED, __HIP_MEMORY_SCOPE_AGENT); SBE(); }
            } else if (pn == 5) {
                ITLOOP { float v[8]; ACC8(v, IT_AI, 0, IT_M, rs[it]); const float s = ssq8(v); st8(b.zCQ + IT_ROW * 512 + 256 + cl0, v); if (fq == 0) __hip_atomic_fetch_add(b.ssq_cq + IT_ROW, s, __ATOMIC_RELAXED, __HIP_MEMORY_SCOPE_AGENT); SBE(); }
                headnorm<64, true, 0>(acc, b.rstd_x, 0.f, b.g_kp, 1.0f, b.zCQ + 256, 512, grow0, 1, wr, wc, fr, fq, b.P, b.rope);
            } else if (pn < 9) {
                headnorm<128, false, 0>(acc, b.rstd_x, 0.f, b.g_mq, LOG2E * 0.08838834764831845f, b.zQM + (pn - 7) * 256, 512, grow0, 0, wr, wc, fr, fq, b.P, nullptr);
            } else { bf16_t* dst = b.zG + (pn - 9) * 256 + cl0;
                ITLOOP { BJLOOP { float v[8]; ACC8(v, IT_AI, bj, IT_M, rs[it]);
#pragma unroll
                    for (int e = 0; e < 8; ++e) v[e] = sigm(v[e]);
                    st8(dst + IT_ROW * 3072 + bj * 128, v); } SBE(); }
            }
        }
        if (KIND == K_MEMKV) {
            if (pn < 2) headnorm<128, false, 0>(acc, b.rstd_mem, 0.f, b.g_mk, 1.0f, b.memkv + pn * 256, 1024, grow0, 0, wr, wc, fr, fq, b.P, nullptr);
            else { float rs[8]; row_scales<0>(b.rstd_mem, 0.f, grow0, rs); ITLOOP { BJLOOP { float v[8]; ACC8(v, IT_AI, bj, IT_M, rs[it]); st8(b.memkv + IT_ROW * 1024 + tc0 + bj * 128, v); } SBE(); } }
        }
        if (KIND == K_Q) {
            const float qs = LOG2E * 0.07216878364870323f;
            if (pn < 4) headnorm<128, false, 1>(acc, b.ssq_cq, 1.0f / 384.0f, b.g_qn, qs, b.q + pn * 256, 1536, grow0, 0, wr, wc, fr, fq, b.P, nullptr);
            else headnorm<64, true, 1>(acc, b.ssq_cq, 1.0f / 384.0f, b.g_qp, qs, b.q + pn * 256, 1536, grow0, 0, wr, wc, fr, fq, b.P, b.rope);
        }
        if (KIND == K_KV) {
            if (pn < 4) headnorm<128, false, 1>(acc, b.ssq_ckv, 1.0f / 256.0f, b.g_kn, 1.0f, b.kv + pn * 256, 2048, grow0, 0, wr, wc, fr, fq, b.P, nullptr);
            else { float rs[8]; row_scales<1>(b.ssq_ckv, 1.0f / 256.0f, grow0, rs); ITLOOP { BJLOOP { float v[8]; ACC8(v, IT_AI, bj, IT_M, rs[it]); st8(b.kv + IT_ROW * 2048 + tc0 + bj * 128, v); } SBE(); } }
        }
        if (KIND == K_OUT) {
            const int brn = br & 3; const bool accum = (br >> 8) != 0;
            u32x4 pg[4][2], pm[4][2];
#define OUT_LOAD(itn, buf) do { const size_t rw_ = (size_t)(grow0 + ((itn) >> 2) * 128 + ((itn) & 3) * 16); BJLOOP { pg[buf][bj] = *(const u32x4*)(b.zG + rw_ * 3072 + brn * 1024 + tc0 + bj * 128); \
                if (accum) pm[buf][bj] = *(const u32x4*)(b.merged + rw_ * 1024 + tc0 + bj * 128); } } while (0)
            OUT_LOAD(0, 0); OUT_LOAD(1, 1); OUT_LOAD(2, 2); OUT_LOAD(3, 3); SBE();
            ITLOOP {
                BJLOOP { const u32x4 gw = pg[it & 3][bj]; const float g[8] = {bflo(gw.x), bfhi(gw.x), bflo(gw.y), bfhi(gw.y), bflo(gw.z), bfhi(gw.z), bflo(gw.w), bfhi(gw.w)};
                    float v[8]; ACC8(v, IT_AI, bj, IT_M, 1.0f);
                    if (accum) { const u32x4 ow = pm[it & 3][bj]; const float o[8] = {bflo(ow.x), bfhi(ow.x), bflo(ow.y), bfhi(ow.y), bflo(ow.z), bfhi(ow.z), bflo(ow.w), bfhi(ow.w)};
#pragma unroll
                        for (int e = 0; e < 8; ++e) v[e] = o[e] + g[e] * v[e];
                    } else {
#pragma unroll
                        for (int e = 0; e < 8; ++e) v[e] = g[e] * v[e]; }
                    st8(b.merged + IT_ROW * 1024 + tc0 + bj * 128, v); }
                SBE(); if (it + 4 < 8) OUT_LOAD(it + 4, it & 3); SBE(); }
#undef OUT_LOAD
        }
        if (KIND == K_WOUT) {
            f32x4 px[4][2][2];
#define RES_LOAD(itn, buf) do { const float* p_ = b.x + (size_t)(grow0 + ((itn) >> 2) * 128 + ((itn) & 3) * 16) * 1024 + tc0; BJLOOP { px[buf][bj][0] = *(const f32x4*)(p_ + bj * 128); px[buf][bj][1] = *(const f32x4*)(p_ + bj * 128 + 4); } } while (0)
            RES_LOAD(0, 0); RES_LOAD(1, 1); RES_LOAD(2, 2); RES_LOAD(3, 3); SBE();
            ITLOOP {
                float s = 0.f;
                BJLOOP { float v[8]; ACC8(v, IT_AI, bj, IT_M, 1.0f); const f32x4 x0 = px[it & 3][bj][0], x1v = px[it & 3][bj][1];
                    v[0] += x0[0]; v[1] += x0[1]; v[2] += x0[2]; v[3] += x0[3]; v[4] += x1v[0]; v[5] += x1v[1]; v[6] += x1v[2]; v[7] += x1v[3];
#pragma unroll
                    for (int e = 0; e < 8; ++e) s += v[e] * v[e];
                    st8(b.x1b + IT_ROW * 1024 + tc0 + bj * 128, v); }
                s = xsum16(s); s = xsum32(s); if (fq == 0) __hip_atomic_fetch_add(b.ssq2 + IT_ROW, s, __ATOMIC_RELAXED, __HIP_MEMORY_SCOPE_AGENT);
                SBE(); if (it + 4 < 8) RES_LOAD(it + 4, it & 3); SBE(); }
#undef RES_LOAD
        }
        if (KIND == K_FF2) {
            u32x4 px[4][2];
#define RES_LOAD(itn, buf) do { const bf16_t* p_ = b.x1b + (size_t)(grow0 + ((itn) >> 2) * 128 + ((itn) & 3) * 16) * 1024 + tc0; BJLOOP { px[buf][bj] = *(const u32x4*)(p_ + bj * 128); } } while (0)
            RES_LOAD(0, 0); RES_LOAD(1, 1); RES_LOAD(2, 2); RES_LOAD(3, 3); SBE();
            ITLOOP {
                BJLOOP { float v[8]; ACC8(v, IT_AI, bj, IT_M, 1.0f); const u32x4 w = px[it & 3][bj];
                    float* op = b.out + IT_ROW * 1024 + tc0 + bj * 128;
                    *(f32x4*)op = (f32x4){v[0] + bflo(w.x), v[1] + bfhi(w.x), v[2] + bflo(w.y), v[3] + bfhi(w.y)}; *(f32x4*)(op + 4) = (f32x4){v[4] + bflo(w.z), v[5] + bfhi(w.z), v[6] + bflo(w.w), v[7] + bfhi(w.w)}; }
                SBE(); if (it + 4 < 8) RES_LOAD(it + 4, it & 3); SBE(); }
#undef RES_LOAD
        }
        if (KIND == K_FF1) {
            float rs[8]; row_scales<1>(b.ssq2, 1.0f / 1024.0f, grow0, rs);
            ITLOOP { BJLOOP { float v[8]; ACC8(v, IT_AI, bj, IT_M, rs[it]);
#pragma unroll
                for (int e = 0; e < 8; ++e) { const float t = fmaxf(v[e], 0.f); v[e] = t * t; }
                st8(b.hdn + IT_ROW * 4096 + tc0 + bj * 128, v); } SBE(); }
        }
#undef IT_AI
#undef IT_M
#undef IT_ROW
#undef ITLOOP
#undef BJLOOP
#undef SBE
    }
};

DI int crow(int r, int hi) { return (r & 3) + 8 * (r >> 2) + 4 * hi; }
DI s16x4 vtr(const LAS char* p) { return __builtin_bit_cast(s16x4, __builtin_amdgcn_ds_read_tr16_b64_v4i16((LAS v4i16_t*)p)); }
#define MFMA32(a, b, c) __builtin_amdgcn_mfma_f32_32x32x16_bf16((a), (b), (c), 0, 0, 0)
DI bf16x8 pack8(const f32x16& x, int o) { u32x4 w; w.x = cvtpk(x[o], x[o + 1]); w.y = cvtpk(x[o + 2], x[o + 3]); w.z = cvtpk(x[o + 4], x[o + 5]); w.w = cvtpk(x[o + 6], x[o + 7]); return __builtin_bit_cast(bf16x8, w); }

template <int DQK, bool CAUSAL, int ABL = 0>
DI void attn_unit(LAS char* lds, const bf16_t* Qa, int pQa, const bf16_t* Qb, int pQb, const bf16_t* Ka, int pKa, const bf16_t* Kb, int pKb,
                  const bf16_t* V, int pV, bf16_t* O, int pO, int q0, int NT) {
    constexpr int KP = DQK * 2 + 16, VP = 320, KBUF = 64 * KP, VBUF = 64 * VP, SLOT = KBUF + VBUF, NDS = DQK / 16, KB = (DQK == 192) ? 3 : 4, NKB = NDS / KB;
    constexpr float THR = 8.0f;
    constexpr int KC16 = KP / 16, NKC = KBUF / 1024, NVC = VBUF / 1024, NCH = NKC + NVC, NOPS = (NCH + 7) / 8;
    static_assert(KBUF % 1024 == 0 && VBUF % 1024 == 0 && 3 * SLOT <= P_OFF + 8192 && (NOPS == 5 || NOPS == 6), "attention ring geometry");
    int tid_ = threadIdx.x; asm volatile("" : "+v"(tid_));
    const int tid = tid_, lane = tid & 63, wid = __builtin_amdgcn_readfirstlane(tid >> 6), r = lane & 31, h = lane >> 5;
    const size_t qrow = (size_t)(q0 + 32 * wid + r);
    asm volatile("s_waitcnt lgkmcnt(0)\n\ts_barrier" ::: "memory");
    const char* gp[NOPS]; unsigned ginc[NOPS]; int loff[NOPS];
#pragma unroll
    for (int j = 0; j < NOPS; ++j) { const int c = (wid + 8 * j < NCH) ? wid + 8 * j : NCH - 1; loff[j] = c * 1024;
        if (c < NKC) { const int idx = 64 * c + lane, row = idx / KC16, cb = idx - row * KC16;
            if (DQK == 192 && cb >= 16 && cb < 24) { gp[j] = (const char*)(Kb + (size_t)row * pKb + (cb - 16) * 8); ginc[j] = 64u * (unsigned)pKb * 2u; }
            else { gp[j] = (const char*)(Ka + (size_t)row * pKa + (cb < 16 ? cb * 8 : 0)); ginc[j] = 64u * (unsigned)pKa * 2u; }
        } else { const int idx = 64 * (c - NKC) + lane, row = idx / 20, cb = idx - row * 20;
            gp[j] = (const char*)(V + (size_t)row * pV + (cb < 16 ? cb * 8 : 0)); ginc[j] = 64u * (unsigned)pV * 2u; } }
#define AT_ISSUE(slot) do { if (ABL & 8) break; _Pragma("unroll") for (int j = 0; j < NOPS; ++j) { \
        __builtin_amdgcn_global_load_lds((const unsigned*)gp[j], (LAS unsigned*)(lds + (slot) * SLOT + loff[j]), 16, 0, 0); gp[j] += ginc[j]; } } while (0)
#define AT_WAITBAR(n) asm volatile("s_waitcnt vmcnt(" #n ") lgkmcnt(0)\n\ts_barrier" ::: "memory")
#define AT_WAIT_NEWEST() do { if (NOPS == 6) AT_WAITBAR(6); else AT_WAITBAR(5); } while (0)
#define SB() __builtin_amdgcn_sched_barrier(0)
#define LDK(dst, bi) do { _Pragma("unroll") for (int j = 0; j < KB; ++j) { dst[2 * j] = *(const LAS bf16x8*)(kb_ + ((bi) * KB + j) * 32); dst[2 * j + 1] = *(const LAS bf16x8*)(kb_ + 32 * KP + ((bi) * KB + j) * 32); } } while (0)
#define MMK(src, bi) do { _Pragma("unroll") for (int j = 0; j < KB; ++j) { \
        if ((bi) == 0 && j == 0) { s0 = MFMA32(src[0], qf[0], negm); s1 = MFMA32(src[1], qf[0], negm); } \
        else { s0 = MFMA32(src[2 * j], qf[(bi) * KB + j], s0); s1 = MFMA32(src[2 * j + 1], qf[(bi) * KB + j], s1); } } } while (0)
#define TRR(dst, off) asm volatile("ds_read_b64_tr_b16 %0, %1 offset:%c2" : "=&v"(dst) : "v"(va_), "i"(off) : "memory")
#define LDV(lo, hi, s) do { _Pragma("unroll") for (int d = 0; d < 4; ++d) { TRR(lo[d], (16 * (s)) * VP + d * 64); TRR(hi[d], (16 * (s) + 8) * VP + d * 64); } } while (0)
#define MMV(lo, hi, s) do { if (ABL & 4) { _Pragma("unroll") for (int d = 0; d < 4; ++d) o[d][0] += (float)lo[d][0] + (float)hi[d][0] + (float)pf[s][d]; break; } _Pragma("unroll") for (int d = 0; d < 4; ++d) o[d] = MFMA32(((bf16x8){lo[d][0], lo[d][1], lo[d][2], lo[d][3], hi[d][0], hi[d][1], hi[d][2], hi[d][3]}), pf[s], o[d]); } while (0)
#define LGKM(n) asm volatile("s_waitcnt lgkmcnt(" #n ")" ::: "memory")
    AT_ISSUE(0);
    if (NT > 1) AT_ISSUE(1);
    bf16x8 qf[NDS];
#pragma unroll
    for (int ds = 0; ds < 8; ++ds) qf[ds] = *(const bf16x8*)(Qa + qrow * pQa + 16 * ds + 8 * h);
    if (DQK == 192) {
#pragma unroll
        for (int ds = 8; ds < NDS; ++ds) qf[ds] = *(const bf16x8*)(Qb + qrow * pQb + 16 * (ds - 8) + 8 * h); }
    AT_WAITBAR(0);
    float mhat = 0.f, lsum = 0.f;
    f32x16 negm;
#pragma unroll
    for (int i = 0; i < 16; ++i) negm[i] = 0.f;
    f32x16 o[4];
#pragma unroll
    for (int d = 0; d < 4; ++d)
#pragma unroll
        for (int i = 0; i < 16; ++i) o[d][i] = 0.f;
    const int qmin = q0 + 32 * wid, qpos = qmin + r;
    const int q4 = (lane & 15) >> 2, p4 = lane & 3, blk = (lane >> 4) & 1;
    int sc = 0, sn2 = 2;
#pragma unroll 1
    for (int t = 0; t < NT; ++t) {
        if (t + 2 < NT) AT_ISSUE(sn2);
        const bool active = !CAUSAL || (64 * t <= qmin + 31);
        if (active) {
            const LAS char* kb_ = lds + sc * SLOT + r * KP + 16 * h; const LAS char* vb_ = lds + sc * SLOT + KBUF + (4 * h + q4) * VP + blk * 32 + p4 * 8;
            f32x16 s0, s1;
            bf16x8 fa[2 * KB], fb[2 * KB];
            SB(); LDK(fa, 0); SB();
#pragma unroll
            for (int bi = 0; bi < NKB; ++bi) {
                if (bi & 1) { if (bi + 1 < NKB) LDK(fa, bi + 1); SB(); MMK(fb, bi); SB(); }
                else { if (bi + 1 < NKB) LDK(fb, bi + 1); SB(); MMK(fa, bi); SB(); } }
            if (CAUSAL && (64 * t + 63 > qmin)) {
#pragma unroll
                for (int i = 0; i < 16; ++i) { const int kv = 64 * t + crow(i, h); if (kv > qpos) s0[i] = -INFINITY; if (kv + 32 > qpos) s1[i] = -INFINITY; } }
            float a_ = fmaxf(fmaxf(s0[0], s0[1]), s1[0]), b_ = fmaxf(fmaxf(s0[2], s0[3]), s1[1]); a_ = fmaxf(fmaxf(a_, s1[2]), s1[3]);
#pragma unroll
            for (int i = 4; i < 16; i += 4) { a_ = fmaxf(fmaxf(a_, s0[i]), s0[i + 1]); b_ = fmaxf(fmaxf(b_, s0[i + 2]), s0[i + 3]); a_ = fmaxf(fmaxf(a_, s1[i]), s1[i + 1]); b_ = fmaxf(fmaxf(b_, s1[i + 2]), s1[i + 3]); }
            const float rm = xmax32(fmaxf(a_, b_));
            const unsigned va_ = (unsigned)(size_t)vb_;
            s16x4 la[4], ha[4], lb[4], hb[4];
            SB(); LDV(la, ha, 0); SB();
            if (t == 0 || __any(rm > THR)) {
                const float dl = (t == 0) ? rm : fmaxf(rm, 0.f), fsc = __builtin_amdgcn_exp2f(-dl);
                mhat += dl; lsum *= fsc;
#pragma unroll
                for (int i = 0; i < 16; ++i) { s0[i] -= dl; s1[i] -= dl; negm[i] = -mhat; }
                if (t != 0) {
#pragma unroll
                    for (int d = 0; d < 4; ++d)
#pragma unroll
                        for (int i = 0; i < 16; ++i) o[d][i] *= fsc; } }
            float ps = 0.f;
#pragma unroll
            for (int i = 0; i < 16; ++i) { s0[i] = __builtin_amdgcn_exp2f(s0[i]); s1[i] = __builtin_amdgcn_exp2f(s1[i]); ps += s0[i] + s1[i]; }
            lsum += ps;
            bf16x8 pf[4]; pf[0] = pack8(s0, 0); pf[1] = pack8(s0, 8); pf[2] = pack8(s1, 0); pf[3] = pack8(s1, 8);
            SB(); LDV(lb, hb, 1); LGKM(8); SB(); MMV(la, ha, 0); SB();
            LDV(la, ha, 2); LGKM(8); SB(); MMV(lb, hb, 1); SB();
            LDV(lb, hb, 3); LGKM(8); SB(); MMV(la, ha, 2); SB();
            LGKM(0); SB(); MMV(lb, hb, 3); SB();
        }
        if (t + 1 < NT) { if (t + 2 < NT) AT_WAIT_NEWEST(); else AT_WAITBAR(0); }
        sn2 = sc; sc = (sc == 2) ? 0 : sc + 1;
    }
    lsum = xsum32(lsum);
    const float inv = 1.0f / lsum;
    bf16_t* orow = O + qrow * pO + 8 * h;
#pragma unroll
    for (int d = 0; d < 4; ++d)
#pragma unroll
        for (int gp = 0; gp < 2; ++gp) { const int g = 2 * gp;
            const unsigned ax = cvtpk(o[d][4 * g] * inv, o[d][4 * g + 1] * inv), ay = cvtpk(o[d][4 * g + 2] * inv, o[d][4 * g + 3] * inv);
            const unsigned bx = cvtpk(o[d][4 * g + 4] * inv, o[d][4 * g + 5] * inv), by = cvtpk(o[d][4 * g + 6] * inv, o[d][4 * g + 7] * inv);
            const auto rx = __builtin_amdgcn_permlane32_swap(ax, bx, false, false); const auto ry = __builtin_amdgcn_permlane32_swap(ay, by, false, false);
            *(u32x4*)(orow + 32 * d + 16 * gp) = (u32x4){rx[0], ry[0], rx[1], ry[1]}; }
#undef AT_ISSUE
#undef AT_WAITBAR
#undef AT_WAIT_NEWEST
#undef SB
#undef LDK
#undef MMK
#undef LDV
#undef MMV
#undef TRR
#undef LGKM
}

DI void gmlp_unit(LAS char* lds, bf16_t* zU, const bf16_t* zV, const float* g_ln, const float* b_ln, const bf16_t* Wb, const float* b_sp, int R0, bool dummy = false) {
    constexpr int WP = 272, VP = 320;
    int tid_ = threadIdx.x; asm volatile("" : "+v"(tid_));
    const int tid = tid_, lane = tid & 63, wid = __builtin_amdgcn_readfirstlane(tid >> 6), r = lane & 31, h = lane >> 5;
    LAS char* Wl = lds; LAS char* Vn = lds + 128 * WP; LAS float* St = (LAS float*)(lds + 128 * WP + 128 * VP);
    __syncthreads();
    { u32x4 rw[16];
#pragma unroll
      for (int i = 0; i < 16; ++i) rw[i] = *(const u32x4*)(zV + (size_t)(R0 + wid * 16 + i) * 512 + lane * 8);
#pragma unroll
      for (int i = 0; i < 16; ++i) { const int s = wid * 16 + i; const u32x4 w = rw[i];
        const float v[8] = {bflo(w.x), bfhi(w.x), bflo(w.y), bfhi(w.y), bflo(w.z), bfhi(w.z), bflo(w.w), bfhi(w.w)};
        float a = 0.f, q = 0.f;
#pragma unroll
        for (int e = 0; e < 8; ++e) { a += v[e]; q += v[e] * v[e]; }
        a = wave_sum(a); q = wave_sum(q);
        const float mu = a * (1.0f / 512.0f), var = fmaxf(q * (1.0f / 512.0f) - mu * mu, 0.f);
        if (lane == 0) { St[2 * s] = mu; St[2 * s + 1] = __builtin_amdgcn_rsqf(var + EPSN); } } }
    const int q4 = (lane & 15) >> 2, p4 = lane & 3, blk = (lane >> 4) & 1, cb = wid & 3, tp = wid >> 2;
    const int lt = tid >> 4, lc8 = (tid & 15) * 8;
    u32x4 pw[4], pv[4]; f32x4 pg[2], pb[2];
#define GM_FETCH(g) do { _Pragma("unroll") for (int i = 0; i < 4; ++i) { pw[i] = *(const u32x4*)(Wb + (size_t)(g) * 16384 + (lt + 32 * i) * 128 + lc8); pv[i] = *(const u32x4*)(zV + (size_t)(R0 + lt + 32 * i) * 512 + (g) * 128 + lc8); } \
        pg[0] = *(const f32x4*)(g_ln + (g) * 128 + lc8); pg[1] = *(const f32x4*)(g_ln + (g) * 128 + lc8 + 4); pb[0] = *(const f32x4*)(b_ln + (g) * 128 + lc8); pb[1] = *(const f32x4*)(b_ln + (g) * 128 + lc8 + 4); } while (0)
    GM_FETCH(0);
#pragma unroll 1
    for (int g = 0; g < 4; ++g) {
        __syncthreads();
#pragma unroll
        for (int i = 0; i < 4; ++i) { const int s = lt + 32 * i;
            *(LAS u32x4*)(Wl + s * WP + lc8 * 2) = pw[i];
            const u32x4 w = pv[i]; float v[8] = {bflo(w.x), bfhi(w.x), bflo(w.y), bfhi(w.y), bflo(w.z), bfhi(w.z), bflo(w.w), bfhi(w.w)};
            const float mu = St[2 * s], rsd = St[2 * s + 1];
#pragma unroll
            for (int e = 0; e < 8; ++e) v[e] = (v[e] - mu) * rsd * pg[e >> 2][e & 3] + pb[e >> 2][e & 3];
            u32x4 o; o.x = cvtpk(v[0], v[1]); o.y = cvtpk(v[2], v[3]); o.z = cvtpk(v[4], v[5]); o.w = cvtpk(v[6], v[7]); *(LAS u32x4*)(Vn + s * VP + lc8 * 2) = o; }
        __syncthreads();
        if (g + 1 < 4) GM_FETCH(g + 1);
        u32x2 uw[2][4]; float bs[2];
#pragma unroll
        for (int tb = 0; tb < 2; ++tb) { const int t = 32 * (2 * tp + tb) + r; bs[tb] = b_sp[g * 128 + t]; const bf16_t* up = zU + (size_t)(R0 + t) * 512 + g * 128 + 32 * cb + 4 * h;
#pragma unroll
            for (int k = 0; k < 4; ++k) uw[tb][k] = *(const u32x2*)(up + 8 * k); }
        f32x16 a0, a1;
#pragma unroll
        for (int i = 0; i < 16; ++i) { a0[i] = 0.f; a1[i] = 0.f; }
        const int tb0 = 2 * tp, tb1 = 2 * tp + 1;
        const LAS char* vb_ = Vn + (8 * h + q4) * VP + cb * 64 + blk * 32 + p4 * 8;
        bf16x8 af[8], b0f[8], b1f[8];
#pragma unroll
        for (int ss = 0; ss < 8; ++ss) {
            if (16 * ss <= 32 * tb1 + 31) {
                const s16x4 lo = vtr(vb_ + (16 * ss) * VP), hi = vtr(vb_ + (16 * ss + 4) * VP);
                af[ss] = (bf16x8){lo[0], lo[1], lo[2], lo[3], hi[0], hi[1], hi[2], hi[3]};
                b1f[ss] = *(const LAS bf16x8*)(Wl + (32 * tb1 + r) * WP + (16 * ss + 8 * h) * 2);
                if (16 * ss <= 32 * tb0 + 31) b0f[ss] = *(const LAS bf16x8*)(Wl + (32 * tb0 + r) * WP + (16 * ss + 8 * h) * 2); } }
        __builtin_amdgcn_sched_barrier(0);
#pragma unroll
        for (int ss = 0; ss < 8; ++ss) {
            if (16 * ss <= 32 * tb1 + 31) { a1 = MFMA32(af[ss], b1f[ss], a1); if (16 * ss <= 32 * tb0 + 31) a0 = MFMA32(af[ss], b0f[ss], a0); } }
#pragma unroll
        for (int tb = 0; tb < 2; ++tb) { const int t = 32 * (2 * tp + tb) + r; bf16_t* up = zU + (size_t)(R0 + t) * 512 + g * 128 + 32 * cb + 4 * h;
#pragma unroll
            for (int k = 0; k < 4; ++k) { const u32x2 u2 = uw[tb][k]; u32x2 w; const f32x16& a = tb ? a1 : a0; const float b_ = bs[tb];
                w.x = cvtpk(bflo(u2.x) * (a[4 * k] + b_), bfhi(u2.x) * (a[4 * k + 1] + b_)); w.y = cvtpk(bflo(u2.y) * (a[4 * k + 2] + b_), bfhi(u2.y) * (a[4 * k + 3] + b_));
                if (dummy) w = u2;
                *(u32x2*)(up + 8 * k) = w; } }
    }
#undef GM_FETCH
}

DI int srccol(int mat, int n) {
    if (mat == 0) { if (n < 1408) return n; if (n < 1472) { const int c = n - 1408; return 1664 + (c & 1) * 32 + (c >> 1); } if (n < 1536) return -1; if (n < 1792) return 1408 + (n - 1536); return n - 64; }
    if (mat == 1) { if (n < 1024) return (n >> 7) * 192 + (n & 127); const int c = n - 1024, hh = c >> 6, cc = c & 63; return hh * 192 + 128 + (cc & 1) * 32 + (cc >> 1); }
    if (mat == 2) { if (n < 1024) return (n >> 7) * 256 + (n & 127); const int c = n - 1024; return (c >> 7) * 256 + 128 + (c & 127); }
    return n;
}
DI void transpose_item(const float* W, const float* gain, int K, int Ns, int Nd, int mat, bf16_t* WT, LAS float* scr, int item, int lane) {
    const int nblk = Nd / 32, kb = item / nblk, nb = item % nblk, k0 = 64 * kb, n0 = 32 * nb;
    const int sc = srccol(mat, n0 + (lane & 31));
#pragma unroll 8
    for (int i = 0; i < 32; ++i) { const int kk = 2 * i + (lane >> 5); float v = 0.f; if (sc >= 0) v = W[(size_t)(k0 + kk) * Ns + sc]; if (gain) v *= gain[k0 + kk]; scr[kk * 33 + (lane & 31)] = v; }
    asm volatile("s_waitcnt lgkmcnt(0)" ::: "memory");
    const int c = lane & 7;
#pragma unroll
    for (int j = 0; j < 4; ++j) { const int n = (lane >> 3) + 8 * j; const LAS float* s = scr + (8 * c) * 33 + n;
        u32x4 o; o.x = cvtpk(s[0 * 33], s[1 * 33]); o.y = cvtpk(s[2 * 33], s[3 * 33]); o.z = cvtpk(s[4 * 33], s[5 * 33]); o.w = cvtpk(s[6 * 33], s[7 * 33]);
        *(u32x4*)(WT + (size_t)(n0 + n) * K + k0 + 8 * c) = o; }
    asm volatile("s_waitcnt lgkmcnt(0)" ::: "memory");
}
template <int NR> DI void rows_to_bf16(const float* x0, bf16_t* o0, float* rstd0, int rstride, int nvalid, int lane) {
    f32x4 v[NR][4];
#pragma unroll
    for (int r = 0; r < NR; ++r) { const f32x4* xr = (const f32x4*)(x0 + (size_t)(r < nvalid ? r : 0) * rstride * 1024) + lane;
#pragma unroll
        for (int j = 0; j < 4; ++j) v[r][j] = xr[64 * j]; }
#pragma unroll
    for (int r = 0; r < NR; ++r) { if (r >= nvalid) break; float s = 0.f;
#pragma unroll
        for (int j = 0; j < 4; ++j) s += (v[r][j][0] * v[r][j][0] + v[r][j][1] * v[r][j][1]) + (v[r][j][2] * v[r][j][2] + v[r][j][3] * v[r][j][3]);
        s = wave_sum(s);
        u32x2* o8 = (u32x2*)(o0 + (size_t)r * rstride * 1024) + lane;
#pragma unroll
        for (int j = 0; j < 4; ++j) { u32x2 w; w.x = cvtpk(v[r][j][0], v[r][j][1]); w.y = cvtpk(v[r][j][2], v[r][j][3]); o8[64 * j] = w; }
        if (lane == 0) rstd0[(size_t)r * rstride] = __builtin_amdgcn_rsqf(s * (1.0f / 1024.0f) + EPSN); }
}


#define RLX_AGENT __ATOMIC_RELAXED, __HIP_MEMORY_SCOPE_AGENT
#define XB_TMO      128
#define XB_XCNT(j)  (256  + 64 * (j))
#define XB_XSUB(j)  (1280 + 64 * (j))
#define XB_XGEN(j)  (2304 + 64 * (j))
#define XB_TOP      3328
#define XB_TOPGEN   3392
#define XCD_BAR_WORDS 3456
#define XB_SPIN_CAP (1u << 18)

__device__ __forceinline__ unsigned xb_ld(unsigned* p)              { return __hip_atomic_load(p, __ATOMIC_RELAXED, __HIP_MEMORY_SCOPE_AGENT); }
__device__ __forceinline__ unsigned xb_add(unsigned* p, unsigned v) { return __hip_atomic_fetch_add(p, v, __ATOMIC_RELAXED, __HIP_MEMORY_SCOPE_AGENT); }
__device__ __forceinline__ unsigned xb_xcc_id() { return (unsigned)__builtin_amdgcn_s_getreg((3 << 11) | 20) & 0xFu; }
#define XB_SPIN(cond, bar) do { unsigned _sp = 0; while (cond) { __builtin_amdgcn_s_sleep(1); \
    if ((++_sp & 255u) == 0u) { if (xb_ld(&(bar)[XB_TMO])) break; if (_sp > XB_SPIN_CAP) { atomicAdd(&(bar)[XB_TMO], 1u); break; } } } } while (0)

struct XcdBarrier {
    unsigned* bar; unsigned x;
    volatile LAS unsigned* st;
};

__device__ __forceinline__ XcdBarrier xcd_barrier_post(unsigned* bar, volatile LAS unsigned* st) {
    XcdBarrier b; b.bar = bar; b.x = xb_xcc_id(); b.st = st;
    if (threadIdx.x == 0) (void)xb_add(&bar[XB_XCNT(b.x)], 1u);
    return b;
}
__device__ __forceinline__ void xcd_barrier_complete(unsigned* bar, unsigned x, unsigned& nloc, unsigned& nx) {
    const unsigned G = gridDim.x * gridDim.y * gridDim.z;
    unsigned sum, cnt, mine, sp = 0u;
    for (;;) {
        sum = 0u; cnt = 0u; mine = 0u;
#pragma unroll
        for (unsigned j = 0; j < 16; ++j) { const unsigned c = xb_ld(&bar[XB_XCNT(j)]); sum += c; cnt += (c > 0u) ? 1u : 0u; mine = (j == x) ? c : mine; }
        if (sum == G) break;
        __builtin_amdgcn_s_sleep(1);
        if ((++sp & 255u) == 0u) { if (xb_ld(&bar[XB_TMO])) break; if (sp > XB_SPIN_CAP) { atomicAdd(&bar[XB_TMO], 1u); break; } }
    }
    nloc = mine > 0u ? mine : 1u; nx = cnt > 0u ? cnt : 1u;
}

__device__ __forceinline__ void xcd_barrier(const XcdBarrier& b) {
    asm volatile("s_waitcnt vmcnt(0)" ::: "memory");
    __syncthreads();
    if (threadIdx.x == 0) {
        unsigned* bar = b.bar;
        __builtin_amdgcn_s_waitcnt(0);
        unsigned nloc = b.st[0], nx = b.st[1];
        if (nloc == 0u) { xcd_barrier_complete(bar, b.x, nloc, nx); b.st[0] = nloc; b.st[1] = nx; }
        const unsigned old = xb_add(&bar[XB_XSUB(b.x)], 1u);
        const unsigned gen = old / nloc;
        if (old + 1u == (gen + 1u) * nloc) {
            __builtin_amdgcn_fence(__ATOMIC_RELEASE, "agent");
            asm volatile("s_waitcnt vmcnt(0)" ::: "memory");
            const unsigned og = xb_add(&bar[XB_TOP], 1u);
            const unsigned tg = og / nx;
            if (og + 1u == (tg + 1u) * nx) xb_add(&bar[XB_TOPGEN], 1u);
            else XB_SPIN(xb_ld(&bar[XB_TOPGEN]) == tg, bar);
            __builtin_amdgcn_fence(__ATOMIC_ACQUIRE, "agent");
            xb_add(&bar[XB_XGEN(b.x)], 1u);
            asm volatile("s_waitcnt vmcnt(0)" ::: "memory");
        } else {
            XB_SPIN(xb_ld(&bar[XB_XGEN(b.x)]) == gen, bar);
            __builtin_amdgcn_fence(__ATOMIC_ACQUIRE, "agent");
            asm volatile("s_waitcnt vmcnt(0)" ::: "memory");
        }
    }
    __syncthreads();
}

struct Args { const float* in[28]; float* out; unsigned char* ws; };

typedef const __attribute__((address_space(4))) Args* KArgP;
DI Bag make_bag(KArgP kp, LAS unsigned char* lds) {
    unsigned char* ws = kp->ws; Bag b;
    b.x = kp->in[0]; b.g_qn = kp->in[9]; b.g_qp = kp->in[10]; b.g_kn = kp->in[11]; b.g_kp = kp->in[12]; b.g_mq = kp->in[19]; b.g_mk = kp->in[20];
    b.rstd_x = (float*)(ws + S_RSX); b.rstd_mem = (float*)(ws + S_RSM); b.ssq_cq = (float*)(ws + S_SSQCQ); b.ssq_ckv = (float*)(ws + S_SSQCKV); b.ssq2 = (float*)(ws + S_SSQ2); b.rope = (const float*)(ws + S_ROPE);
    b.zU = (bf16_t*)(ws + A_ZU); b.zV = (bf16_t*)(ws + A_ZV); b.zCQ = (bf16_t*)(ws + A_ZCQ); b.zCKV = (bf16_t*)(ws + A_ZCKV); b.zQM = (bf16_t*)(ws + A_ZQM); b.zG = (bf16_t*)(ws + A_ZG);
    b.q = (bf16_t*)(ws + A_Q); b.kv = (bf16_t*)kp->out; b.memkv = (bf16_t*)(ws + A_MEMKV); b.merged = (bf16_t*)kp->out; b.x1b = (bf16_t*)(ws + A_X1B); b.hdn = (bf16_t*)(ws + A_HDN);
    b.x1 = (float*)(ws + A_X1); b.out = kp->out; b.P = (LAS float*)(lds + P_OFF);
    return b;
}
#define WSP(off) ((bf16_t*)(kp->ws + (off)))
#define FRESH() asm volatile("" : "+s"(kp))
#ifndef PHM
#define PHM 0xff
#endif
#ifndef P2M
#define P2M 15
#endif
__global__ void __launch_bounds__(512) mega_fwd(Args a_unused) {
    extern __shared__ __attribute__((aligned(16))) unsigned char lds_raw[];
    cg::grid_group grid = cg::this_grid();
    LAS unsigned char* lds = (LAS unsigned char*)lds_raw;
    const int tid = threadIdx.x, lane = tid & 63, wave = __builtin_amdgcn_readfirstlane(tid >> 6), G = gridDim.x, bid = blockIdx.x;
    KArgP kp = (KArgP)__builtin_amdgcn_kernarg_segment_ptr();
    (void)a_unused;
    volatile LAS unsigned* bst = (volatile LAS unsigned*)(lds + P_OFF + 8192);
    if (tid == 0) { bst[0] = 0u; bst[1] = 0u; }
    if (bid == 0) { unsigned* bw = (unsigned*)(kp->ws + S_BAR); for (int i = tid; i < XCD_BAR_WORDS; i += 512) __hip_atomic_store(bw + i, 0u, RLX_AGENT); }
    __syncthreads();

#ifndef REP_P0
#define REP_P0 1
#endif
#ifndef REP_P6
#define REP_P6 1
#endif
#pragma unroll 1
    for (int rep0 = 0; rep0 < REP_P0; ++rep0) {
        FRESH();
        unsigned char* ws = kp->ws;
        LAS float* scr = (LAS float*)(lds + wave * 16384);
        const int gw = bid * 8 + wave, NGW = G * 8;
        constexpr int I0 = 16 * 168, I1 = 6 * 48, I2 = 4 * 64, I3 = 16 * 32, I4 = 8 * 32, I5 = 16 * 32, I6 = 8 * 32, I7 = 16 * 32, I8 = 16 * 128, I9 = 64 * 32;
        constexpr int NIT = I0 + I1 + I2 + I3 + I4 + I5 + I6 + I7;
        for (int it = gw; it < NIT; it += NGW) {
            int r = it;
            if (r < I0) { transpose_item(kp->in[4], kp->in[3], 1024, 5312, 5376, 0, WSP(W_IN), scr, r, lane); continue; } r -= I0;
            if (r < I1) { transpose_item(kp->in[6], kp->in[5], 384, 1536, 1536, 1, WSP(W_UQ), scr, r, lane); continue; } r -= I1;
            if (r < I2) { transpose_item(kp->in[8], kp->in[7], 256, 2048, 2048, 2, WSP(W_UKV), scr, r, lane); continue; } r -= I2;
            if (r < I3) { transpose_item(kp->in[18], kp->in[17], 1024, 1024, 1024, 3, WSP(W_MKV), scr, r, lane); continue; } r -= I3;
            if (r < I4) { transpose_item(kp->in[21], nullptr, 512, 1024, 1024, 3, WSP(W_OGM), scr, r, lane); continue; } r -= I4;
            if (r < I5) { transpose_item(kp->in[22], nullptr, 1024, 1024, 1024, 3, WSP(W_OMLA), scr, r, lane); continue; } r -= I5;
            if (r < I6) { transpose_item(kp->in[23], nullptr, 512, 1024, 1024, 3, WSP(W_OMEM), scr, r, lane); continue; } r -= I6;
            transpose_item(kp->in[24], nullptr, 1024, 1024, 1024, 3, WSP(W_WOUT), scr, r, lane);
        }
        { const float* x = kp->in[0]; bf16_t* xb = WSP(A_XB); float* rsx = (float*)(ws + S_RSX);
          for (int m = gw; m < T; m += 4 * NGW) rows_to_bf16<4>(x + (size_t)m * 1024, xb + (size_t)m * 1024, rsx + m, NGW, (T - 1 - m) / NGW + 1, lane); }
        { const float* mem = kp->in[1]; bf16_t* memb = WSP(A_MEMB); float* rsm = (float*)(ws + S_RSM);
          for (int m = gw; m < MEMT; m += 4 * NGW) rows_to_bf16<4>(mem + (size_t)m * 1024, memb + (size_t)m * 1024, rsm + m, NGW, (MEMT - 1 - m) / NGW + 1, lane); }
        { const float* wsp = kp->in[15]; bf16_t* wb = WSP(S_WSP);
          for (int idx = bid * 512 + tid; idx < 4 * 128 * 128 / 2; idx += G * 512) { const int e = idx * 2, t = (e >> 7) & 127, sc = e & 127; const f32x2_t w = *(const f32x2_t*)(wsp + e);
              *(unsigned*)(wb + e) = cvtpk(sc <= t ? w[0] : 0.f, sc + 1 <= t ? w[1] : 0.f); } }
        { float* z1 = (float*)(ws + S_SSQCQ); float* z2 = (float*)(ws + S_SSQCKV); float* z3 = (float*)(ws + S_SSQ2);
          for (int i = bid * 512 + tid; i < T; i += G * 512) { z1[i] = 0.f; z2[i] = 0.f; z3[i] = 0.f; } }
        float* rope = (float*)(ws + S_ROPE); const int* pos = (const int*)kp->in[2];
        for (int idx = bid * 512 + tid; idx < T * 32; idx += G * 512) { const int row = idx >> 5, p = idx & 31;
            const float invf = exp2f(-(float)(2 * p) * (13.287712379549449f / 64.0f)); const float ang = (float)pos[row] * invf;
            const double rev = (double)ang * 0.15915494309189535; const float fr_ = (float)(rev - __builtin_rint(rev));
            rope[2 * (size_t)idx] = __builtin_amdgcn_cosf(fr_); rope[2 * (size_t)idx + 1] = __builtin_amdgcn_sinf(fr_); }
    }
    grid.sync();
    const XcdBarrier xbar = xcd_barrier_post((unsigned*)(kp->ws + S_BAR), bst);
    if (PHM & 2) {
#ifndef REP_P1
#define REP_P1 1
#endif
#pragma unroll 1
        for (int r1 = 0; r1 < REP_P1; ++r1) { FRESH(); Bag b = make_bag(kp, lds);
          if (REP_P1 > 1 && r1 + 1 < REP_P1) { b.ssq_cq = (float*)(kp->ws + 48 * MiB); b.ssq_ckv = (float*)(kp->ws + 49 * MiB); }
          pg8::Gemm g{WSP(A_XB), WSP(W_IN), T, 5376, 1024, 1024}; pg8::StaticOrder S; S.init(T, 5376, G, bid); Epi<K_Z> E{b, 0};
          pg8::gemm_phase<Epi<K_Z>, pg8::StaticOrder, true, true, 1024, 1024>(lds, g, S, E); }
        { const int c2 = (bid + 128) % G;
          if (G <= 128 || c2 >= 128) { FRESH(); __syncthreads();
            LAS float* scr = (LAS float*)(lds + wave * 16384);
            const int rank = (G > 128) ? c2 - 128 : bid, nidle = (G > 128) ? G - 128 : G;
            constexpr int I8 = 16 * 128, I9 = 64 * 32;
            for (int it = rank * 8 + wave; it < I8 + I9; it += nidle * 8) {
                if (it < I8) transpose_item(kp->in[26], kp->in[25], 1024, 4096, 4096, 3, WSP(W_FF1), scr, it, lane);
                else transpose_item(kp->in[27], nullptr, 4096, 1024, 1024, 3, WSP(W_FF2), scr, it - I8, lane); }
            __syncthreads(); } }
        { FRESH(); const Bag b = make_bag(kp, lds);
          pg8::Gemm g2{WSP(A_MEMB), WSP(W_MKV), MEMT, 1024, 1024, 1024}; pg8::StaticOrder S2; S2.init(MEMT, 1024, G, (bid + 128) % G); Epi<K_MEMKV> E2{b, 0};
          pg8::gemm_phase<Epi<K_MEMKV>, pg8::StaticOrder, true, true, 1024, 1024>(lds, g2, S2, E2); }
    }
    xcd_barrier(xbar);
    if (PHM & 4) {
#pragma unroll 1
      for (int k2 = 0; k2 < 2; ++k2) { const int part = (bid & 1) ? 1 - k2 : k2;
      if (part == 0) {
#ifndef REP_P2G
#define REP_P2G 1
#endif
#ifndef REP_GM
#define REP_GM 1
#endif
#pragma unroll 1
        for (int rg = 0; rg < REP_P2G; ++rg) {
        if (P2M & 1) { FRESH(); const Bag b = make_bag(kp, lds);
          pg8::Gemm g{b.zCQ, WSP(W_UQ), T, 1536, 384, 512}; pg8::StaticOrder S; S.init(T, 1536, G, bid); Epi<K_Q> E{b, 0};
          pg8::gemm_phase<Epi<K_Q>, pg8::StaticOrder, true, true, 384, 512>(lds, g, S, E); }
        if (P2M & 2) { FRESH(); const Bag b = make_bag(kp, lds);
          pg8::Gemm g2{b.zCKV, WSP(W_UKV), T, 2048, 256, 256}; pg8::StaticOrder S2; S2.init(T, 2048, G, bid); Epi<K_KV> E2{b, 0};
          pg8::gemm_phase<Epi<K_KV>, pg8::StaticOrder, true, true, 256, 256>(lds, g2, S2, E2); }
        }
      } else {
        __syncthreads();
        if (P2M & 4) { FRESH();
#pragma unroll 1
          for (int u = bid; u < 512 * REP_GM; u += G) gmlp_unit((LAS char*)lds, WSP(A_ZU), WSP(A_ZV), kp->in[13], kp->in[14], WSP(S_WSP), kp->in[16], (u & 511) * 128, REP_GM > 1 && u < 512 * (REP_GM - 1)); }
        if (P2M & 8) { FRESH(); bf16_t* zQM = WSP(A_ZQM); const bf16_t* memkv = WSP(A_MEMKV);
#pragma unroll 1
          for (int u0 = bid; u0 < 1024; u0 += G) { int u = u0;
            if (G == 256) { const int L = (u0 >> 8) * 32 + (bid >> 3); u = ((L >> 3) * 8 + (bid & 7)) * 8 + (L & 7); }
            const int bb = u >> 5, hh = (u >> 3) & 3, qb = u & 7;
            bf16_t* Q = zQM + (size_t)bb * SEQ * 512 + hh * 128; const bf16_t* Kp = memkv + (size_t)bb * MEML * 1024 + hh * 128;
            attn_unit<128, false>((LAS char*)lds, Q, 512, nullptr, 0, Kp, 1024, nullptr, 0, Kp + 512, 1024, Q, 512, qb * 256, 4); } }
      }
      __syncthreads();
      }
    }
    xcd_barrier(xbar);
    if (PHM & 8) {
        FRESH(); bf16_t* q = WSP(A_Q); const bf16_t* kv = (const bf16_t*)kp->out; const bf16_t* zCQ = WSP(A_ZCQ);
#ifndef REP_P3
#define REP_P3 1
#endif
#pragma unroll 1
        for (int it = bid; it < 1024 * REP_P3; it += G) { int bh = it & 255, pr = (it >> 8) & 3;
            if (G == 256) { bh = ((bid & 7) + 8 * (bid >> 5)) + 64 * ((it >> 8) & 3); pr = (bid >> 3) & 3; }
            const int bb = bh >> 3, hh = bh & 7;
            bf16_t* Qa = q + (size_t)bb * SEQ * 1536 + hh * 128; const bf16_t* Qb = q + (size_t)bb * SEQ * 1536 + 1024 + hh * 64;
            const bf16_t* Ka = kv + (size_t)bb * SEQ * 2048 + hh * 128; const bf16_t* Kb = zCQ + (size_t)bb * SEQ * 512 + 384; const bf16_t* Vp = Ka + 1024;
            bf16_t* Op = Qa; int pO = 1536;
            if (REP_P3 > 1 && it < 1024 * (REP_P3 - 1)) { Op = WSP(A_ZV) + (size_t)bb * SEQ * 512 + (hh & 3) * 128; pO = 512; }
#pragma unroll 1
            for (int k = 0; k < 2; ++k) { const int qb = k ? 7 - pr : pr;
#if defined(P3ABL)
                if (REP_P3 > 1 && it < 1024 * (REP_P3 - 1)) attn_unit<192, true, P3ABL>((LAS char*)lds, Qa, 1536, Qb, 1536, Ka, 2048, Kb, 512, Vp, 2048, Op, pO, qb * 256, 4 * (qb + 1)); else
#endif
                attn_unit<192, true>((LAS char*)lds, Qa, 1536, Qb, 1536, Ka, 2048, Kb, 512, Vp, 2048, Op, pO, qb * 256, 4 * (qb + 1)); } }
    }
    xcd_barrier(xbar);
    if (PHM & 16) {
        pg8::StaticOrder S; S.init(T, 1024, G, bid);
#ifndef REP_P4
#define REP_P4 1
#endif
#pragma unroll 1
        for (int r4 = 0; r4 < REP_P4; ++r4) {
#pragma unroll 1
        for (int k = 0; k < 3; ++k) {
            const int brn = (k == 2) ? 2 : ((bid & 1) ? 1 - k : k), fl = brn | ((k > 0) << 8);
            FRESH(); const Bag b = make_bag(kp, lds); Epi<K_OUT> E{b, fl};
            if (brn == 1) { pg8::Gemm g{b.q, WSP(W_OMLA), T, 1024, 1024, 1536}; pg8::gemm_phase<Epi<K_OUT>, pg8::StaticOrder, true, true, 1024, 1536>(lds, g, S, E); }
            else { pg8::Gemm g{brn == 0 ? b.zU : b.zQM, brn == 0 ? WSP(W_OGM) : WSP(W_OMEM), T, 1024, 512, 512}; pg8::gemm_phase<Epi<K_OUT>, pg8::StaticOrder, true, true, 512, 512>(lds, g, S, E); }
        }
        }
    }
    xcd_barrier(xbar);
#ifndef REP_P5
#define REP_P5 1
#endif
#pragma unroll 1
    for (int r5 = 0; r5 < REP_P5; ++r5) { FRESH(); Bag b = make_bag(kp, lds); if (REP_P5 > 1 && r5 + 1 < REP_P5) b.ssq2 = (float*)(kp->ws + 48 * MiB); pg8::Gemm g{b.merged, WSP(W_WOUT), T, 1024, 1024, 1024}; pg8::StaticOrder S; S.init(T, 1024, G, bid); Epi<K_WOUT> E{b, 0}; pg8::gemm_phase<Epi<K_WOUT>, pg8::StaticOrder, true, true, 1024, 1024>(lds, g, S, E); }
    xcd_barrier(xbar);
#pragma unroll 1
    for (int rep6 = 0; rep6 < REP_P6; ++rep6) { FRESH(); const Bag b = make_bag(kp, lds); pg8::Gemm g{b.x1b, WSP(W_FF1), T, 4096, 1024, 1024}; pg8::StaticOrder S; S.init(T, 4096, G, bid); Epi<K_FF1> E{b, 0}; pg8::gemm_phase<Epi<K_FF1>, pg8::StaticOrder, true, true, 1024, 1024>(lds, g, S, E); }
    xcd_barrier(xbar);
#ifndef REP_P7
#define REP_P7 1
#endif
#pragma unroll 1
    for (int r7 = 0; r7 < REP_P7; ++r7) { FRESH(); const Bag b = make_bag(kp, lds); pg8::Gemm g{b.hdn, WSP(W_FF2), T, 1024, 4096, 4096}; pg8::StaticOrder S; S.init(T, 1024, G, bid); Epi<K_FF2> E{b, 0}; pg8::gemm_phase<Epi<K_FF2>, pg8::StaticOrder, true, true, 4096, 4096>(lds, g, S, E); }
}

extern "C" void kernel_launch(void* const* d_in, const int* in_sizes, int n_in, void* d_out, int out_size, void* d_ws, size_t ws_size, hipStream_t stream) {
    static int grid_blocks = 0;
    if (grid_blocks == 0) {
        if (n_in != 28 || ws_size < WS_NEED) { fprintf(stderr, "kernel_launch: need 28 inputs and %zu bytes of workspace (got %d, %zu)\n", (size_t)WS_NEED, n_in, ws_size); grid_blocks = -1; return; }
        int dev = 0, cus = 0, per_cu = 0;
        hipGetDevice(&dev); hipDeviceGetAttribute(&cus, hipDeviceAttributeMultiprocessorCount, dev);
        if (hipFuncSetAttribute((const void*)mega_fwd, hipFuncAttributeMaxDynamicSharedMemorySize, LDS_BYTES) != hipSuccess) { fprintf(stderr, "kernel_launch: hipFuncSetAttribute failed\n"); grid_blocks = -1; return; }
        if (hipOccupancyMaxActiveBlocksPerMultiprocessor(&per_cu, (const void*)mega_fwd, 512, LDS_BYTES) != hipSuccess || per_cu < 1) { fprintf(stderr, "kernel_launch: occupancy query gave %d\n", per_cu); per_cu = 1; }
        (void)hipGetLastError();
        grid_blocks = cus * (per_cu > 1 ? 1 : per_cu);
    }
    if (grid_blocks < 0) return;
    Args a{};
    for (int i = 0; i < 28; ++i) a.in[i] = (const float*)d_in[i];
    a.out = (float*)d_out; a.ws = (unsigned char*)d_ws;
    void* args[] = {&a};
    hipError_t e = hipLaunchCooperativeKernel((const void*)mega_fwd, dim3(grid_blocks), dim3(512), args, LDS_BYTES, stream);
    if (e != hipSuccess) fprintf(stderr, "cooperative launch failed: %s (grid %d)\n", hipGetErrorString(e), grid_blocks);
}
```

```cpp
#include <hip/hip_runtime.h>
#include <hip/hip_cooperative_groups.h>
#include <cstdio>
#include <cstdint>
namespace cg = cooperative_groups;
namespace pg8 {
#define PG8_LAS __attribute__((address_space(3)))
typedef unsigned short bf16_t;
typedef short bf16x8 __attribute__((ext_vector_type(8)));
typedef float f32x4 __attribute__((ext_vector_type(4)));
typedef unsigned u32x4 __attribute__((ext_vector_type(4)));
constexpr int BM = 256, BK = 64, HALF = 128, HTB = HALF * BK * 2  , STAGE_BYTES = 8 * HTB, NXCD = 8, WGM = 8;

__host__ __device__ __forceinline__ int lds_byte(int r, int c) { const int st = (r >> 4) * 2 + (c >> 5), rr = r & 15, cc = c & 31, ob = rr * 64 + cc * 2; return st * 1024 + (ob ^ (((ob >> 9) & 1) << 5)); }
__host__ __device__ __forceinline__ void stage_rc(int b, int& R, int& C) { const int st = b / 1024, sb = b % 1024, swz = sb ^ (((sb >> 9) & 1) << 5); R = (st >> 1) * 16 + swz / 64; C = (st & 1) * 32 + (swz % 64) / 2; }
__host__ __device__ __forceinline__ int perm32(int rho) { const int n = rho >> 4, i = rho & 15; return 8 * (i >> 2) + 4 * n + (i & 3); }

struct Unit { int pm, pn; };
struct Gemm { const bf16_t* A; const bf16_t* Bt; int M, N, K, lda; };

struct StaticOrder {
    int nM, nN, nwg, G, c;
    __host__ __device__ void init(int M, int N, int G_, int c_) { nM = M / BM; nN = N / BM; nwg = nM * nN; G = G_; c = c_; }
    __host__ __device__ bool next(int i, Unit& u) const {
        const long L = (long)i * G + c; if (L >= nwg) return false;
        int wgid = (int)L; { const int q = nwg / NXCD, r = nwg % NXCD, xcd = wgid % NXCD, off = wgid / NXCD; wgid = (xcd < r ? xcd * (q + 1) : r * (q + 1) + (xcd - r) * q) + off; }
        const int nig = WGM * nN, gid = wgid / nig, fm = gid * WGM, gsz = (nM - fm) < WGM ? (nM - fm) : WGM;
        u.pm = fm + ((wgid % nig) % gsz); u.pn = (wgid % nig) / gsz; return true;
    }
    __device__ __forceinline__ void a_ready(const Unit&) const {}
    __device__ __forceinline__ void done(const Unit&) const {}
};

template <class Epi, class Sched, bool ALIGN_EPI = false, bool SP2 = false, int KC = 0, int LDAC = 0>
__device__ __forceinline__ void gemm_phase(PG8_LAS unsigned char* lds, const Gemm g, const Sched& S, const Epi& E) {
    int tid_ = threadIdx.x; asm volatile("" : "+v"(tid_));
    const int tid = tid_, wid = __builtin_amdgcn_readfirstlane(tid >> 6), lane = tid & 63, wr = wid >> 2, wc = wid & 3, fr = lane & 15, fq = lane >> 4;
    const int K = KC ? KC : g.K, nt = K / BK, lda_ = LDAC ? LDAC : g.lda;
    unsigned voffA[2], voffB[2];
#pragma unroll
    for (int i = 0; i < 2; ++i) { int R, C; stage_rc(tid * 16 + i * 8192, R, C); const int Rb = Epi::PERM ? ((R & ~31) + perm32(R & 31)) : R;
        voffA[i] = (unsigned)(R * lda_ + C) * 2u; voffB[i] = (unsigned)(Rb * K + C) * 2u; }
    const size_t kstep = (size_t)(BK * 2);
    const size_t hstepA = (size_t)HALF * lda_ * 2, hstepB = (size_t)HALF * K * 2;
    const size_t tstepA = 2 * hstepA, tstepB = 2 * hstepB;
    const unsigned ldsw = (unsigned)wid * 1024u;
    const int aoff = lds_byte(wr * 64 + fr, fq * 8), boff = lds_byte(wc * 32 + fr, fq * 8);
#define PG8_SA(b, h) (((b) * 2 + (h)) * HTB)
#define PG8_SB(b, h) ((4 + (b) * 2 + (h)) * HTB)
#define PG8_STAGE(bufoff, gbase, voff) do { _Pragma("unroll") for (int _i = 0; _i < 2; ++_i) \
        __builtin_amdgcn_global_load_lds((const unsigned*)((const char*)(gbase) + (voff)[_i]), (PG8_LAS unsigned*)(lds + (bufoff) + ldsw + _i * 8192), 16, 0, 0); } while (0)
#define PG8_LDA(dst, b, h) do { _Pragma("unroll") for (int m = 0; m < 4; ++m) _Pragma("unroll") for (int k = 0; k < 2; ++k) dst[m][k] = *(const PG8_LAS bf16x8*)(lds + PG8_SA(b, h) + aoff + m * 2048 + k * 1024); } while (0)
#define PG8_LDB(dst, b, h) do { _Pragma("unroll") for (int n = 0; n < 2; ++n) _Pragma("unroll") for (int k = 0; k < 2; ++k) dst[n][k] = *(const PG8_LAS bf16x8*)(lds + PG8_SB(b, h) + boff + n * 2048 + k * 1024); } while (0)
#define PG8_MMA(ai, bj, At, Bt) do { __builtin_amdgcn_s_setprio(1); _Pragma("unroll") for (int m = 0; m < 4; ++m) _Pragma("unroll") for (int n = 0; n < 2; ++n) _Pragma("unroll") for (int k = 0; k < 2; ++k) \
        acc[ai][bj][m][n] = __builtin_amdgcn_mfma_f32_16x16x32_bf16(Bt[n][k], At[m][k], acc[ai][bj][m][n], 0, 0, 0); __builtin_amdgcn_s_setprio(0); } while (0)
#define PG8_WAIT_V(n) asm volatile("s_waitcnt vmcnt(" #n ")" ::: "memory")
#define PG8_WAIT_L(n) asm volatile("s_waitcnt lgkmcnt(" #n ")" ::: "memory")
#define PG8_BAR __builtin_amdgcn_s_barrier()
#define PG8_SCHED __builtin_amdgcn_sched_barrier(0)
    Unit cur, nxt; int ui = 0;
    if (!S.next(0, cur)) return;
    f32x4 acc[2][2][4][2];
#pragma unroll
    for (int a = 0; a < 2; ++a)
#pragma unroll
        for (int b = 0; b < 2; ++b)
#pragma unroll
            for (int m = 0; m < 4; ++m)
#pragma unroll
                for (int n = 0; n < 2; ++n) acc[a][b][m][n] = (f32x4){0.f, 0.f, 0.f, 0.f};
    bf16x8 At[4][2], B0[2][2], B1[2][2];
    const char* cA = (const char*)g.A + (size_t)cur.pm * tstepA; const char* cB = (const char*)g.Bt + (size_t)cur.pn * tstepB;
    S.a_ready(cur);
    if constexpr (SP2) {
        PG8_STAGE(PG8_SB(0, 0), cB, voffB); PG8_STAGE(PG8_SB(0, 1), cB + hstepB, voffB); PG8_STAGE(PG8_SA(0, 0), cA, voffA); PG8_STAGE(PG8_SA(0, 1), cA + hstepA, voffA);
        if (wr == 1) PG8_BAR;
        PG8_WAIT_V(2); PG8_BAR;
        PG8_STAGE(PG8_SB(1, 0), cB + kstep, voffB); PG8_STAGE(PG8_SA(1, 0), cA + kstep, voffA); PG8_STAGE(PG8_SB(1, 1), cB + hstepB + kstep, voffB);
        PG8_WAIT_V(6); PG8_BAR;
    } else {
        PG8_STAGE(PG8_SB(0, 0), cB, voffB); PG8_STAGE(PG8_SA(0, 0), cA, voffA); PG8_STAGE(PG8_SB(0, 1), cB + hstepB, voffB); PG8_STAGE(PG8_SA(0, 1), cA + hstepA, voffA);
        if (wr == 1) PG8_BAR;
        PG8_WAIT_V(4); PG8_BAR;
        PG8_STAGE(PG8_SB(1, 0), cB + kstep, voffB); PG8_STAGE(PG8_SA(1, 0), cA + kstep, voffA); PG8_STAGE(PG8_SB(1, 1), cB + hstepB + kstep, voffB);
        PG8_WAIT_V(6); PG8_BAR;
    }
    for (;;) {
        const bool has_next = S.next(ui + 1, nxt);
        const char* nA = has_next ? (const char*)g.A + (size_t)nxt.pm * tstepA : cA; const char* nB = has_next ? (const char*)g.Bt + (size_t)nxt.pn * tstepB : cB;
#pragma unroll 1
        for (int t = 0; t < nt; t += 2) {
            const bool last = (t == nt - 2);
            const char* a1 = cA + (size_t)(t + 1) * kstep;
            const char* a2 = last ? nA : cA + (size_t)(t + 2) * kstep; const char* b2 = last ? nB : cB + (size_t)(t + 2) * kstep;
            const char* a3 = a2 + kstep; const char* b3 = b2 + kstep;
            if (last && has_next) S.a_ready(nxt);
            if constexpr (SP2) {
            PG8_LDB(B0, 0, 0); PG8_LDB(B1, 0, 1); PG8_SCHED; PG8_LDA(At, 0, 0); PG8_STAGE(PG8_SA(1, 1), a1 + hstepA, voffA);
            PG8_WAIT_V(8); PG8_WAIT_L(0); PG8_BAR; PG8_MMA(0, 0, At, B0); PG8_MMA(0, 1, At, B1); PG8_BAR; PG8_SCHED;
            PG8_LDA(At, 0, 1); PG8_STAGE(PG8_SB(0, 0), b2, voffB); PG8_STAGE(PG8_SB(0, 1), b2 + hstepB, voffB); PG8_STAGE(PG8_SA(0, 0), a2, voffA);
            PG8_WAIT_V(8); PG8_WAIT_L(0); PG8_BAR; PG8_MMA(1, 0, At, B0); PG8_MMA(1, 1, At, B1); PG8_BAR; PG8_SCHED;
            PG8_LDB(B0, 1, 0); PG8_LDB(B1, 1, 1); PG8_SCHED; PG8_LDA(At, 1, 0); PG8_STAGE(PG8_SA(0, 1), a2 + hstepA, voffA);
            PG8_WAIT_V(8); PG8_WAIT_L(0); PG8_BAR; PG8_MMA(0, 0, At, B0); PG8_MMA(0, 1, At, B1); PG8_BAR; PG8_SCHED;
            PG8_LDA(At, 1, 1); PG8_STAGE(PG8_SB(1, 0), b3, voffB); PG8_STAGE(PG8_SB(1, 1), b3 + hstepB, voffB); PG8_STAGE(PG8_SA(1, 0), a3, voffA);
            PG8_WAIT_V(8); PG8_WAIT_L(0); PG8_BAR; PG8_MMA(1, 0, At, B0); PG8_MMA(1, 1, At, B1); PG8_BAR; PG8_SCHED;
            } else {
            PG8_LDB(B0, 0, 0); PG8_SCHED; PG8_LDA(At, 0, 0); PG8_STAGE(PG8_SA(1, 1), a1 + hstepA, voffA);
            PG8_WAIT_L(8); PG8_BAR; PG8_WAIT_L(0); PG8_MMA(0, 0, At, B0); PG8_BAR; PG8_SCHED;
            PG8_LDB(B1, 0, 1); PG8_STAGE(PG8_SB(0, 0), b2, voffB);
            PG8_BAR; PG8_WAIT_L(0); PG8_MMA(0, 1, At, B1); PG8_BAR;
            PG8_LDA(At, 0, 1); PG8_STAGE(PG8_SA(0, 0), a2, voffA);
            PG8_BAR; PG8_WAIT_L(0); PG8_MMA(1, 0, At, B0); PG8_BAR; PG8_SCHED;
            PG8_STAGE(PG8_SB(0, 1), b2 + hstepB, voffB);
            PG8_WAIT_V(6); PG8_BAR; PG8_MMA(1, 1, At, B1); PG8_BAR;
            PG8_LDB(B0, 1, 0); PG8_SCHED; PG8_LDA(At, 1, 0); PG8_STAGE(PG8_SA(0, 1), a2 + hstepA, voffA);
            PG8_WAIT_L(8); PG8_BAR; PG8_WAIT_L(0); PG8_MMA(0, 0, At, B0); PG8_BAR; PG8_SCHED;
            PG8_LDB(B1, 1, 1); PG8_STAGE(PG8_SB(1, 0), b3, voffB);
            PG8_BAR; PG8_WAIT_L(0); PG8_MMA(0, 1, At, B1); PG8_BAR;
            PG8_LDA(At, 1, 1); PG8_STAGE(PG8_SA(1, 0), a3, voffA);
            PG8_BAR; PG8_WAIT_L(0); PG8_MMA(1, 0, At, B0); PG8_BAR; PG8_SCHED;
            PG8_STAGE(PG8_SB(1, 1), b3 + hstepB, voffB);
            PG8_WAIT_V(6); PG8_BAR; PG8_MMA(1, 1, At, B1); PG8_BAR;
            }
        }
        if constexpr (ALIGN_EPI) { if (wr == 0) PG8_BAR; }
        if constexpr (!Epi::AFTER_DRAIN) { E(acc, cur, wr, wc, fr, fq); S.done(cur); }
        if (!has_next) break;
#pragma unroll
        for (int a = 0; a < 2; ++a)
#pragma unroll
            for (int b = 0; b < 2; ++b)
#pragma unroll
                for (int m = 0; m < 4; ++m)
#pragma unroll
                    for (int n = 0; n < 2; ++n) acc[a][b][m][n] = (f32x4){0.f, 0.f, 0.f, 0.f};
        cur = nxt; cA = nA; cB = nB; ++ui;
        if constexpr (ALIGN_EPI) { if (wr == 1) PG8_BAR; }
    }
    PG8_WAIT_V(0);
    if constexpr (!ALIGN_EPI) { if (wr == 0) PG8_BAR; }
    PG8_BAR;
    if constexpr (Epi::AFTER_DRAIN) { E.fused(acc, cur, wr, wc, fr, fq, lds, wid, lane); S.done(cur); }
#undef PG8_SA
#undef PG8_SB
#undef PG8_STAGE
#undef PG8_LDA
#undef PG8_LDB
#undef PG8_MMA
#undef PG8_WAIT_V
#undef PG8_WAIT_L
#undef PG8_BAR
#undef PG8_SCHED
}
}

#define LAS __attribute__((address_space(3)))
#define DI __device__ __forceinline__
using pg8::bf16_t; using pg8::bf16x8; using pg8::f32x4; using pg8::u32x4;
typedef short s16x4 __attribute__((ext_vector_type(4)));
typedef short v4i16_t __attribute__((ext_vector_type(4)));
typedef float f32x16 __attribute__((ext_vector_type(16)));
typedef float f32x2_t __attribute__((ext_vector_type(2)));
typedef __bf16 bf16x2_t __attribute__((ext_vector_type(2)));
typedef unsigned u32x2 __attribute__((ext_vector_type(2)));

constexpr int T = 65536, SEQ = 2048, NB = 32, DM = 1024, MEMT = 8192, MEML = 256;
constexpr float EPSN = 1e-6f, LOG2E = 1.4426950408889634f;
constexpr size_t MiB = 1u << 20;
constexpr size_t W_IN = 0, W_UQ = 11 * MiB, W_UKV = 13 * MiB, W_MKV = 14 * MiB, W_OGM = 16 * MiB, W_OMLA = 17 * MiB, W_OMEM = 19 * MiB, W_WOUT = 20 * MiB, W_FF1 = 22 * MiB, W_FF2 = 30 * MiB;
constexpr size_t S_WSP = 39 * MiB + 512 * 1024;
constexpr size_t S_BAR = 39 * MiB;
constexpr size_t S_RSX = 40 * MiB, S_RSM = S_RSX + 256 * 1024, S_SSQCQ = 41 * MiB, S_SSQCKV = 44 * MiB, S_SSQ2 = 46 * MiB, S_ROPE = 50 * MiB;
constexpr size_t A_ZU = 72 * MiB, A_ZV = 136 * MiB, A_X1B = 72 * MiB, A_MEMB = 200 * MiB, A_MEMKV = 216 * MiB, A_Q = 232 * MiB, A_XB = 232 * MiB;
constexpr size_t A_ZCQ = 424 * MiB, A_ZCKV = 488 * MiB, A_ZQM = 520 * MiB, A_ZG = 584 * MiB, A_HDN = 200 * MiB, A_X1 = 712 * MiB, WS_NEED = 968 * MiB;
constexpr int RING_BYTES = 131072, P_OFF = RING_BYTES, LDS_BYTES = 147456;

DI unsigned cvtpk(float lo, float hi) { f32x2_t v = {lo, hi}; bf16x2_t b = __builtin_convertvector(v, bf16x2_t); return __builtin_bit_cast(unsigned, b); }
DI float bflo(unsigned w) { return __uint_as_float(w << 16); }
DI float bfhi(unsigned w) { return __uint_as_float(w & 0xffff0000u); }
DI float wave_sum(float v) {
    v += __builtin_bit_cast(float, __builtin_amdgcn_update_dpp(0, __builtin_bit_cast(int, v), 0x121, 0xf, 0xf, false));
    v += __builtin_bit_cast(float, __builtin_amdgcn_update_dpp(0, __builtin_bit_cast(int, v), 0x122, 0xf, 0xf, false));
    v += __builtin_bit_cast(float, __builtin_amdgcn_update_dpp(0, __builtin_bit_cast(int, v), 0x124, 0xf, 0xf, false));
    v += __builtin_bit_cast(float, __builtin_amdgcn_update_dpp(0, __builtin_bit_cast(int, v), 0x128, 0xf, 0xf, false));
    { const auto r = __builtin_amdgcn_permlane16_swap(__float_as_uint(v), __float_as_uint(v), false, false); v = __uint_as_float(r[0]) + __uint_as_float(r[1]); }
    { const auto r = __builtin_amdgcn_permlane32_swap(__float_as_uint(v), __float_as_uint(v), false, false); v = __uint_as_float(r[0]) + __uint_as_float(r[1]); }
    return v;
}
DI float xsum16(float s) { const auto r = __builtin_amdgcn_permlane16_swap(__float_as_uint(s), __float_as_uint(s), false, false); return __uint_as_float(r[0]) + __uint_as_float(r[1]); }
DI float xsum32(float s) { const auto r = __builtin_amdgcn_permlane32_swap(__float_as_uint(s), __float_as_uint(s), false, false); return __uint_as_float(r[0]) + __uint_as_float(r[1]); }
DI float xmax32(float s) { const auto r = __builtin_amdgcn_permlane32_swap(__float_as_uint(s), __float_as_uint(s), false, false); return fmaxf(__uint_as_float(r[0]), __uint_as_float(r[1])); }
DI float gelu_t(float x) { const float t = x + 0.044715f * x * x * x; return x * __builtin_amdgcn_rcpf(1.0f + __builtin_amdgcn_exp2f(-2.3022082f * t)); }
DI float sigm(float x) { return __builtin_amdgcn_rcpf(1.0f + __builtin_amdgcn_exp2f(-LOG2E * x)); }
DI void st8(bf16_t* p, const float (&v)[8]) { u32x4 w; w.x = cvtpk(v[0], v[1]); w.y = cvtpk(v[2], v[3]); w.z = cvtpk(v[4], v[5]); w.w = cvtpk(v[6], v[7]); *(u32x4*)p = w; }
DI void ld8f(const float* p, float (&v)[8]) { const f32x4 a = *(const f32x4*)p, b = *(const f32x4*)(p + 4); v[0] = a[0]; v[1] = a[1]; v[2] = a[2]; v[3] = a[3]; v[4] = b[0]; v[5] = b[1]; v[6] = b[2]; v[7] = b[3]; }
DI void ld8b(const bf16_t* p, float (&v)[8]) { const u32x4 w = *(const u32x4*)p; v[0] = bflo(w.x); v[1] = bfhi(w.x); v[2] = bflo(w.y); v[3] = bfhi(w.y); v[4] = bflo(w.z); v[5] = bfhi(w.z); v[6] = bflo(w.w); v[7] = bfhi(w.w); }
#define EPI_BAR() do { asm volatile("s_waitcnt lgkmcnt(0)" ::: "memory"); __builtin_amdgcn_s_barrier(); asm volatile("" ::: "memory"); } while (0)

struct Bag {
    const float *x, *g_qn, *g_qp, *g_kn, *g_kp, *g_mq, *g_mk;
    float *rstd_x, *rstd_mem, *ssq_cq, *ssq_ckv, *ssq2; const float* rope;
    bf16_t *zU, *zV, *zCQ, *zCKV, *zQM, *zG, *q, *kv, *memkv, *merged, *x1b, *hdn;
    float *x1, *out;
    LAS float* P;
};
typedef f32x4 AccT[2][2][4][2];
#define ACC8(v, ai, bj, m, s) do { const f32x4 a_ = acc[ai][bj][m][0] * (s), b_ = acc[ai][bj][m][1] * (s); v[0] = a_[0]; v[1] = a_[1]; v[2] = a_[2]; v[3] = a_[3]; v[4] = b_[0]; v[5] = b_[1]; v[6] = b_[2]; v[7] = b_[3]; } while (0)
DI float ssq8(const float (&v)[8]) { float s = (v[0] * v[0] + v[1] * v[1]) + (v[2] * v[2] + v[3] * v[3]) + (v[4] * v[4] + v[5] * v[5]) + (v[6] * v[6] + v[7] * v[7]); s = xsum16(s); s = xsum32(s); return s; }

template <int NS> DI void row_scales(const float* rsp, float inv, int grow0, float (&rs)[8]) {
#pragma unroll
    for (int it = 0; it < 8; ++it) rs[it] = rsp[grow0 + (it >> 2) * 128 + (it & 3) * 16];
    if (NS != 0) {
#pragma unroll
        for (int it = 0; it < 8; ++it) rs[it] = __builtin_amdgcn_rsqf(rs[it] * inv + EPSN); }
}
template <int GS, bool ROPE, int NS>
DI void headnorm(const AccT& acc, const float* rsp, float rs_inv, const float* gain, float oscale, bf16_t* dst, int ld, int grow0, int bj_lo,
                 int wr, int wc, int fr, int fq, LAS float* P, const float* rope) {
    const int rowl0 = wr * 64 + fr, cl0 = wc * 32 + 8 * fq, ch = cl0 & (GS - 1);
#pragma unroll
    for (int ai = 0; ai < 2; ++ai)
#pragma unroll
        for (int m = 0; m < 4; ++m)
#pragma unroll
            for (int bj = 0; bj < 2; ++bj) { if (bj < bj_lo) continue; float v[8]; ACC8(v, ai, bj, m, 1.0f); const float s = ssq8(v);
                if (fq == 0) P[(ai * 128 + m * 16 + rowl0) * 8 + bj * 4 + wc] = s; }
    EPI_BAR();
    float rs[8]; row_scales<NS>(rsp, rs_inv, grow0, rs);
    float g8[8];
    if (ROPE) { const int p0 = ch >> 1;
#pragma unroll
        for (int e = 0; e < 8; ++e) g8[e] = gain[(e & 1) * 32 + p0 + (e >> 1)] * oscale;
    } else { ld8f(gain + ch, g8);
#pragma unroll
        for (int e = 0; e < 8; ++e) g8[e] *= oscale; }
    f32x4 cs[4][2];
#define CS_LOAD(itn) do { const size_t gn_ = (size_t)(grow0 + ((itn) >> 2) * 128 + ((itn) & 3) * 16); cs[(itn) & 3][0] = *(const f32x4*)(rope + gn_ * 64 + ch); cs[(itn) & 3][1] = *(const f32x4*)(rope + gn_ * 64 + ch + 4); } while (0)
    if (ROPE) { CS_LOAD(0); CS_LOAD(1); CS_LOAD(2); CS_LOAD(3); }
#pragma unroll
    for (int it = 0; it < 8; ++it) { const int ai = it >> 2, m = it & 3, rl = ai * 128 + m * 16 + rowl0; const size_t grow = (size_t)(grow0 + ai * 128 + m * 16);
        __builtin_amdgcn_sched_barrier(0);
#pragma unroll
        for (int bj = 0; bj < 2; ++bj) { if (bj < bj_lo) continue;
            const f32x4 p4 = *(const LAS f32x4*)(P + rl * 8 + bj * 4);
            const float tot = ((GS == 128) ? (p4[0] + p4[1]) + (p4[2] + p4[3]) : (wc < 2 ? p4[0] + p4[1] : p4[2] + p4[3])) * rs[it] * rs[it];
            const float r = __builtin_amdgcn_rsqf(tot * (1.0f / GS) + EPSN) * rs[it];
            float v[8]; ACC8(v, ai, bj, m, r);
#pragma unroll
            for (int e = 0; e < 8; ++e) v[e] *= g8[e];
            if (ROPE) { const f32x4 c0 = cs[it & 3][0], c1 = cs[it & 3][1]; const float cv[8] = {c0[0], c0[1], c0[2], c0[3], c1[0], c1[1], c1[2], c1[3]};
#pragma unroll
                for (int k = 0; k < 4; ++k) { const float a = v[2 * k], b = v[2 * k + 1], c = cv[2 * k], sn = cv[2 * k + 1]; v[2 * k] = a * c - b * sn; v[2 * k + 1] = b * c + a * sn; } }
            st8(dst + grow * ld + bj * 128 + cl0, v); }
        __builtin_amdgcn_sched_barrier(0); if (ROPE && it + 4 < 8) CS_LOAD(it + 4); __builtin_amdgcn_sched_barrier(0); }
#undef CS_LOAD
}

enum { K_Z = 0, K_MEMKV, K_Q, K_KV, K_OUT, K_WOUT, K_FF1, K_FF2 };
template <int KIND> struct Epi {
    static constexpr bool PERM = true, AFTER_DRAIN = false;
    Bag b; int br;
    DI void operator()(const AccT& acc, const pg8::Unit& u, int wr, int wc, int fr_in, int fq_in) const {
        int ln_; asm volatile("v_mbcnt_lo_u32_b32 %0, -1, 0\n\tv_mbcnt_hi_u32_b32 %0, -1, %0" : "=v"(ln_));
        const int fr = ln_ & 15, fq = ln_ >> 4; (void)fr_in; (void)fq_in;
        const int grow0 = u.pm * 256 + wr * 64 + fr, cl0 = wc * 32 + 8 * fq, pn = u.pn, tc0 = pn * 256 + cl0;
#define IT_AI (it >> 2)
#define IT_M (it & 3)
#define IT_ROW ((size_t)(grow0 + (it >> 2) * 128 + (it & 3) * 16))
#define ITLOOP _Pragma("unroll") for (int it = 0; it < 8; ++it)
#define BJLOOP _Pragma("unroll") for (int bj = 0; bj < 2; ++bj)
#define SBE() __builtin_amdgcn_sched_barrier(0)
        if (KIND == K_Z) {
            float rs[8]; row_scales<0>(b.rstd_x, 0.f, grow0, rs);
            if (pn < 4) { bf16_t* dst = (pn < 2 ? b.zU : b.zV) + (pn & 1) * 256 + cl0;
                ITLOOP { BJLOOP { float v[8]; ACC8(v, IT_AI, bj, IT_M, rs[it]);
#pragma unroll
                    for (int e = 0; e < 8; ++e) v[e] = gelu_t(v[e]);
                    st8(dst + IT_ROW * 512 + bj * 128, v); } SBE(); }
            } else if (pn == 4 || pn == 6) { bf16_t* dst = (pn == 4 ? b.zCQ : b.zCKV) + cl0; const int ld = (pn == 4) ? 512 : 256; float* sq = (pn == 4) ? b.ssq_cq : b.ssq_ckv;
                ITLOOP { float s = 0.f; BJLOOP { float v[8]; ACC8(v, IT_AI, bj, IT_M, rs[it]); s += ssq8(v); st8(dst + IT_ROW * ld + bj * 128, v); } if (fq == 0) __hip_atomic_fetch_add(sq + IT_ROW, s, __ATOMIC_RELAXED, __HIP_MEMORY_SCOPE_AGENT); SBE(); }
            } else if (pn == 5) {
                ITLOOP { float v[8]; ACC8(v, IT_AI, 0, IT_M, rs[it]); const float s = ssq8(v); st8(b.zCQ + IT_ROW * 512 + 256 + cl0, v); if (fq == 0) __hip_atomic_fetch_add(b.ssq_cq + IT_ROW, s, __ATOMIC_RELAXED, __HIP_MEMORY_SCOPE_AGENT); SBE(); }
                headnorm<64, true, 0>(acc, b.rstd_x, 0.f, b.g_kp, 1.0f, b.zCQ + 256, 512, grow0, 1, wr, wc, fr, fq, b.P, b.rope);
            } else if (pn < 9) {
                headnorm<128, false, 0>(acc, b.rstd_x, 0.f, b.g_mq, LOG2E * 0.08838834764831845f, b.zQM + (pn - 7) * 256, 512, grow0, 0, wr, wc, fr, fq, b.P, nullptr);
            } else { bf16_t* dst = b.zG + (pn - 9) * 256 + cl0;
                ITLOOP { BJLOOP { float v[8]; ACC8(v, IT_AI, bj, IT_M, rs[it]);
#pragma unroll
                    for (int e = 0; e < 8; ++e) v[e] = sigm(v[e]);
                    st8(dst + IT_ROW * 3072 + bj * 128, v); } SBE(); }
            }
        }
        if (KIND == K_MEMKV) {
            if (pn < 2) headnorm<128, false, 0>(acc, b.rstd_mem, 0.f, b.g_mk, 1.0f, b.memkv + pn * 256, 1024, grow0, 0, wr, wc, fr, fq, b.P, nullptr);
            else { float rs[8]; row_scales<0>(b.rstd_mem, 0.f, grow0, rs); ITLOOP { BJLOOP { float v[8]; ACC8(v, IT_AI, bj, IT_M, rs[it]); st8(b.memkv + IT_ROW * 1024 + tc0 + bj * 128, v); } SBE(); } }
        }
        if (KIND == K_Q) {
            const float qs = LOG2E * 0.07216878364870323f;
            if (pn < 4) headnorm<128, false, 1>(acc, b.ssq_cq, 1.0f / 384.0f, b.g_qn, qs, b.q + pn * 256, 1536, grow0, 0, wr, wc, fr, fq, b.P, nullptr);
            else headnorm<64, true, 1>(acc, b.ssq_cq, 1.0f / 384.0f, b.g_qp, qs, b.q + pn * 256, 1536, grow0, 0, wr, wc, fr, fq, b.P, b.rope);
        }
        if (KIND == K_KV) {
            if (pn < 4) headnorm<128, false, 1>(acc, b.ssq_ckv, 1.0f / 256.0f, b.g_kn, 1.0f, b.kv + pn * 256, 2048, grow0, 0, wr, wc, fr, fq, b.P, nullptr);
            else { float rs[8]; row_scales<1>(b.ssq_ckv, 1.0f / 256.0f, grow0, rs); ITLOOP { BJLOOP { float v[8]; ACC8(v, IT_AI, bj, IT_M, rs[it]); st8(b.kv + IT_ROW * 2048 + tc0 + bj * 128, v); } SBE(); } }
        }
        if (KIND == K_OUT) {
            const int brn = br & 3; const bool accum = (br >> 8) != 0;
            u32x4 pg[4][2], pm[4][2];
#define OUT_LOAD(itn, buf) do { const size_t rw_ = (size_t)(grow0 + ((itn) >> 2) * 128 + ((itn) & 3) * 16); BJLOOP { pg[buf][bj] = *(const u32x4*)(b.zG + rw_ * 3072 + brn * 1024 + tc0 + bj * 128); \
                if (accum) pm[buf][bj] = *(const u32x4*)(b.merged + rw_ * 1024 + tc0 + bj * 128); } } while (0)
            OUT_LOAD(0, 0); OUT_LOAD(1, 1); OUT_LOAD(2, 2); OUT_LOAD(3, 3); SBE();
            ITLOOP {
                BJLOOP { const u32x4 gw = pg[it & 3][bj]; const float g[8] = {bflo(gw.x), bfhi(gw.x), bflo(gw.y), bfhi(gw.y), bflo(gw.z), bfhi(gw.z), bflo(gw.w), bfhi(gw.w)};
                    float v[8]; ACC8(v, IT_AI, bj, IT_M, 1.0f);
                    if (accum) { const u32x4 ow = pm[it & 3][bj]; const float o[8] = {bflo(ow.x), bfhi(ow.x), bflo(ow.y), bfhi(ow.y), bflo(ow.z), bfhi(ow.z), bflo(ow.w), bfhi(ow.w)};
#pragma unroll
                        for (int e = 0; e < 8; ++e) v[e] = o[e] + g[e] * v[e];
                    } else {
#pragma unroll
                        for (int e = 0; e < 8; ++e) v[e] = g[e] * v[e]; }
                    st8(b.merged + IT_ROW * 1024 + tc0 + bj * 128, v); }
                SBE(); if (it + 4 < 8) OUT_LOAD(it + 4, it & 3); SBE(); }
#undef OUT_LOAD
        }
        if (KIND == K_WOUT) {
            f32x4 px[4][2][2];
#define RES_LOAD(itn, buf) do { const float* p_ = b.x + (size_t)(grow0 + ((itn) >> 2) * 128 + ((itn) & 3) * 16) * 1024 + tc0; BJLOOP { px[buf][bj][0] = *(const f32x4*)(p_ + bj * 128); px[buf][bj][1] = *(const f32x4*)(p_ + bj * 128 + 4); } } while (0)
            RES_LOAD(0, 0); RES_LOAD(1, 1); RES_LOAD(2, 2); RES_LOAD(3, 3); SBE();
            ITLOOP {
                float s = 0.f;
                BJLOOP { float v[8]; ACC8(v, IT_AI, bj, IT_M, 1.0f); const f32x4 x0 = px[it & 3][bj][0], x1v = px[it & 3][bj][1];
                    v[0] += x0[0]; v[1] += x0[1]; v[2] += x0[2]; v[3] += x0[3]; v[4] += x1v[0]; v[5] += x1v[1]; v[6] += x1v[2]; v[7] += x1v[3];
#pragma unroll
                    for (int e = 0; e < 8; ++e) s += v[e] * v[e];
                    st8(b.x1b + IT_ROW * 1024 + tc0 + bj * 128, v); }
                s = xsum16(s); s = xsum32(s); if (fq == 0) __hip_atomic_fetch_add(b.ssq2 + IT_ROW, s, __ATOMIC_RELAXED, __HIP_MEMORY_SCOPE_AGENT);
                SBE(); if (it + 4 < 8) RES_LOAD(it + 4, it & 3); SBE(); }
#undef RES_LOAD
        }
        if (KIND == K_FF2) {
            u32x4 px[4][2];
#define RES_LOAD(itn, buf) do { const bf16_t* p_ = b.x1b + (size_t)(grow0 + ((itn) >> 2) * 128 + ((itn) & 3) * 16) * 1024 + tc0; BJLOOP { px[buf][bj] = *(const u32x4*)(p_ + bj * 128); } } while (0)
            RES_LOAD(0, 0); RES_LOAD(1, 1); RES_LOAD(2, 2); RES_LOAD(3, 3); SBE();
            ITLOOP {
                BJLOOP { float v[8]; ACC8(v, IT_AI, bj, IT_M, 1.0f); const u32x4 w = px[it & 3][bj];
                    float* op = b.out + IT_ROW * 1024 + tc0 + bj * 128;
                    *(f32x4*)op = (f32x4){v[0] + bflo(w.x), v[1] + bfhi(w.x), v[2] + bflo(w.y), v[3] + bfhi(w.y)}; *(f32x4*)(op + 4) = (f32x4){v[4] + bflo(w.z), v[5] + bfhi(w.z), v[6] + bflo(w.w), v[7] + bfhi(w.w)}; }
                SBE(); if (it + 4 < 8) RES_LOAD(it + 4, it & 3); SBE(); }
#undef RES_LOAD
        }
        if (KIND == K_FF1) {
            float rs[8]; row_scales<1>(b.ssq2, 1.0f / 1024.0f, grow0, rs);
            ITLOOP { BJLOOP { float v[8]; ACC8(v, IT_AI, bj, IT_M, rs[it]);
#pragma unroll
                for (int e = 0; e < 8; ++e) { const float t = fmaxf(v[e], 0.f); v[e] = t * t; }
                st8(b.hdn + IT_ROW * 4096 + tc0 + bj * 128, v); } SBE(); }
        }
#undef IT_AI
#undef IT_M
#undef IT_ROW
#undef ITLOOP
#undef BJLOOP
#undef SBE
    }
};

DI int crow(int r, int hi) { return (r & 3) + 8 * (r >> 2) + 4 * hi; }
DI s16x4 vtr(const LAS char* p) { return __builtin_bit_cast(s16x4, __builtin_amdgcn_ds_read_tr16_b64_v4i16((LAS v4i16_t*)p)); }
#define MFMA32(a, b, c) __builtin_amdgcn_mfma_f32_32x32x16_bf16((a), (b), (c), 0, 0, 0)
DI bf16x8 pack8(const f32x16& x, int o) { u32x4 w; w.x = cvtpk(x[o], x[o + 1]); w.y = cvtpk(x[o + 2], x[o + 3]); w.z = cvtpk(x[o + 4], x[o + 5]); w.w = cvtpk(x[o + 6], x[o + 7]); return __builtin_bit_cast(bf16x8, w); }

template <int DQK, bool CAUSAL, int ABL = 0>
DI void attn_unit(LAS char* lds, const bf16_t* Qa, int pQa, const bf16_t* Qb, int pQb, const bf16_t* Ka, int pKa, const bf16_t* Kb, int pKb,
                  const bf16_t* V, int pV, bf16_t* O, int pO, int q0, int NT) {
    constexpr int KP = DQK * 2 + 16, VP = 320, KBUF = 64 * KP, VBUF = 64 * VP, SLOT = KBUF + VBUF, NDS = DQK / 16, HB = (DQK == 192) ? 2 : 4, NBH = NDS / HB;
    constexpr float THR = 8.0f;
    constexpr int KC16 = KP / 16, NKC = KBUF / 1024, NVC = VBUF / 1024, NCH = NKC + NVC, NOPS = (NCH + 7) / 8;
    static_assert(KBUF % 1024 == 0 && VBUF % 1024 == 0 && 3 * SLOT <= P_OFF + 8192 && (NOPS == 5 || NOPS == 6), "attention ring geometry");
    int tid_ = threadIdx.x; asm volatile("" : "+v"(tid_));
    const int tid = tid_, lane = tid & 63, wid = __builtin_amdgcn_readfirstlane(tid >> 6), r = lane & 31, h = lane >> 5;
    const size_t qrow = (size_t)(q0 + 32 * wid + r);
    asm volatile("s_waitcnt lgkmcnt(0)\n\ts_barrier" ::: "memory");
    const char* gp[NOPS]; int loff[NOPS]; unsigned peflags = 0u;
#pragma unroll
    for (int j = 0; j < NOPS; ++j) { const int c = (wid + 8 * j < NCH) ? wid + 8 * j : NCH - 1; loff[j] = c * 1024;
        if (c < NKC) { const int idx = 64 * c + lane, row = idx / KC16, cb = idx - row * KC16;
            if (DQK == 192 && cb >= 16 && cb < 24) { gp[j] = (const char*)(Kb + (size_t)row * pKb + (cb - 16) * 8); peflags |= 1u << j; }
            else { gp[j] = (const char*)(Ka + (size_t)row * pKa + (cb < 16 ? cb * 8 : 0)); }
        } else { const int idx = 64 * (c - NKC) + lane, row = idx / 20, cb = idx - row * 20;
            gp[j] = (const char*)(V + (size_t)row * pV + (cb < 16 ? cb * 8 : 0)); } }
    const unsigned incA = 64u * (unsigned)pKa * 2u, incB = 64u * (unsigned)pKb * 2u;
#define AT_ISSUE(slot) do { if (ABL & 8) break; _Pragma("unroll") for (int j = 0; j < NOPS; ++j) { \
        __builtin_amdgcn_global_load_lds((const unsigned*)gp[j], (LAS unsigned*)(lds + (slot) * SLOT + loff[j]), 16, 0, 0); gp[j] += ((peflags >> j) & 1u) ? incB : incA; } } while (0)
#define AT_WAITBAR(n) asm volatile("s_waitcnt vmcnt(" #n ") lgkmcnt(0)\n\ts_barrier" ::: "memory")
#define AT_WAIT_NEWEST() do { if (NOPS == 6) AT_WAITBAR(6); else AT_WAITBAR(5); } while (0)
#define SB() __builtin_amdgcn_sched_barrier(0)
#define LDH(dst, half, b2) do { _Pragma("unroll") for (int j = 0; j < HB; ++j) dst[j] = *(const LAS bf16x8*)(kb_ + (half) * 32 * KP + ((b2) * HB + j) * 32); } while (0)
#define MMH(S, src, b2) do { _Pragma("unroll") for (int j = 0; j < HB; ++j) { if ((b2) == 0 && j == 0) S = MFMA32(src[0], qf[0], negm); else S = MFMA32(src[j], qf[(b2) * HB + j], S); } } while (0)
#define TRR(dst, off) asm volatile("ds_read_b64_tr_b16 %0, %1 offset:%c2" : "=&v"(dst) : "v"(va_), "i"(off) : "memory")
#define LDV(lo, hi, s) do { _Pragma("unroll") for (int d = 0; d < 4; ++d) { TRR(lo[d], (16 * (s)) * VP + d * 64); TRR(hi[d], (16 * (s) + 8) * VP + d * 64); } } while (0)
#define MMV(lo, hi, s) do { if (ABL & 4) { _Pragma("unroll") for (int d = 0; d < 4; ++d) o[d][0] += (float)lo[d][0] + (float)hi[d][0] + (float)pf[s][d]; break; } _Pragma("unroll") for (int d = 0; d < 4; ++d) o[d] = MFMA32(((bf16x8){lo[d][0], lo[d][1], lo[d][2], lo[d][3], hi[d][0], hi[d][1], hi[d][2], hi[d][3]}), pf[s], o[d]); } while (0)
#define LGKM(n) asm volatile("s_waitcnt lgkmcnt(" #n ")" ::: "memory")
    AT_ISSUE(0);
    if (NT > 1) AT_ISSUE(1);
    bf16x8 qf[NDS];
#pragma unroll
    for (int ds = 0; ds < 8; ++ds) qf[ds] = *(const bf16x8*)(Qa + qrow * pQa + 16 * ds + 8 * h);
    if (DQK == 192) {
#pragma unroll
        for (int ds = 8; ds < NDS; ++ds) qf[ds] = *(const bf16x8*)(Qb + qrow * pQb + 16 * (ds - 8) + 8 * h); }
    AT_WAITBAR(0);
    float mhat = 0.f, lsum = 0.f;
    f32x16 negm;
#pragma unroll
    for (int i = 0; i < 16; ++i) negm[i] = 0.f;
    f32x16 o[4];
#pragma unroll
    for (int d = 0; d < 4; ++d)
#pragma unroll
        for (int i = 0; i < 16; ++i) o[d][i] = 0.f;
    const int qmin = q0 + 32 * wid, qpos = qmin + r;
    const int q4 = (lane & 15) >> 2, p4 = lane & 3, blk = (lane >> 4) & 1;
    int sc = 0, sn2 = 2;
#pragma unroll 1
    for (int t = 0; t < NT; ++t) {
        if (t + 2 < NT) AT_ISSUE(sn2);
        const bool active = !CAUSAL || (64 * t <= qmin + 31);
        if (active) {
            const LAS char* kb_ = lds + sc * SLOT + r * KP + 16 * h; const LAS char* vb_ = lds + sc * SLOT + KBUF + (4 * h + q4) * VP + blk * 32 + p4 * 8;
            f32x16 s0, s1;
            bf16x8 fa[HB], fb[HB];
            const unsigned va_ = (unsigned)(size_t)vb_;
            s16x4 la[4], ha[4];
            float m0 = 0.f, ps = 0.f; bf16x8 pf[4];
            SB(); LDH(fa, 0, 0); SB();
#pragma unroll
            for (int bb = 0; bb < 2 * NBH; ++bb) {
                const int nb = bb + 1;
                if (nb < 2 * NBH) { if (nb & 1) LDH(fb, nb / NBH, nb % NBH); else LDH(fa, nb / NBH, nb % NBH); }
                SB();
                if (bb < NBH) { if (bb & 1) MMH(s0, fb, bb % NBH); else MMH(s0, fa, bb % NBH); }
                else          { if (bb & 1) MMH(s1, fb, bb % NBH); else MMH(s1, fa, bb % NBH); }
                if (bb == NBH) {
                    if (CAUSAL && (64 * t + 31 > qmin)) {
#pragma unroll
                        for (int i = 0; i < 16; ++i) { const int kv = 64 * t + crow(i, h); if (kv > qpos) s0[i] = -INFINITY; } }
                    float m0b = fmaxf(fmaxf(s0[3], s0[4]), s0[5]); m0 = fmaxf(fmaxf(s0[0], s0[1]), s0[2]);
#pragma unroll
                    for (int i = 6; i < 15; i += 3) { m0 = fmaxf(fmaxf(m0, s0[i]), s0[i + 1]); m0b = fmaxf(m0b, s0[i + 2]); }
                    m0 = fmaxf(fmaxf(m0, m0b), s0[15]);
#pragma unroll
                    for (int i = 0; i < 16; ++i) { s0[i] = __builtin_amdgcn_exp2f(s0[i]); ps += s0[i]; }
                    pf[0] = pack8(s0, 0); pf[1] = pack8(s0, 8); }
                SB(); }
            LDV(la, ha, 0); SB(); LGKM(0); SB();
            MMV(la, ha, 0); SB(); LDV(la, ha, 1); LGKM(0); SB(); MMV(la, ha, 1); SB(); LDV(la, ha, 2); SB();
            if (CAUSAL && (64 * t + 63 > qmin)) {
#pragma unroll
                for (int i = 0; i < 16; ++i) { const int kv = 64 * t + 32 + crow(i, h); if (kv > qpos) s1[i] = -INFINITY; } }
            float m1 = fmaxf(fmaxf(s1[0], s1[1]), s1[2]), m1b = fmaxf(fmaxf(s1[3], s1[4]), s1[5]);
#pragma unroll
            for (int i = 6; i < 15; i += 3) { m1 = fmaxf(fmaxf(m1, s1[i]), s1[i + 1]); m1b = fmaxf(m1b, s1[i + 2]); }
            m1 = fmaxf(fmaxf(m1, m1b), s1[15]);
            const float rm = xmax32(fmaxf(m0, m1));
            if (t == 0 || __any(rm > THR)) {
                const float dl = (t == 0) ? rm : fmaxf(rm, 0.f), fsc = __builtin_amdgcn_exp2f(-dl);
                mhat += dl; lsum *= fsc; ps *= fsc;
#pragma unroll
                for (int i = 0; i < 16; ++i) { s1[i] -= dl; negm[i] = -mhat; }
#pragma unroll
                for (int d = 0; d < 4; ++d)
#pragma unroll
                    for (int i = 0; i < 16; ++i) o[d][i] *= fsc; }
#pragma unroll
            for (int i = 0; i < 16; ++i) { s1[i] = __builtin_amdgcn_exp2f(s1[i]); ps += s1[i]; }
            lsum += ps;
            pf[2] = pack8(s1, 0); pf[3] = pack8(s1, 8);
            SB(); LGKM(0); SB(); MMV(la, ha, 2); SB(); LDV(la, ha, 3); LGKM(0); SB(); MMV(la, ha, 3); SB();
        }
        if (t + 1 < NT) { if (t + 2 < NT) AT_WAIT_NEWEST(); else AT_WAITBAR(0); }
        sn2 = sc; sc = (sc == 2) ? 0 : sc + 1;
    }
    lsum = xsum32(lsum);
    const float inv = 1.0f / lsum;
    bf16_t* orow = O + qrow * pO + 8 * h;
#pragma unroll
    for (int d = 0; d < 4; ++d)
#pragma unroll
        for (int gp = 0; gp < 2; ++gp) { const int g = 2 * gp;
            const unsigned ax = cvtpk(o[d][4 * g] * inv, o[d][4 * g + 1] * inv), ay = cvtpk(o[d][4 * g + 2] * inv, o[d][4 * g + 3] * inv);
            const unsigned bx = cvtpk(o[d][4 * g + 4] * inv, o[d][4 * g + 5] * inv), by = cvtpk(o[d][4 * g + 6] * inv, o[d][4 * g + 7] * inv);
            const auto rx = __builtin_amdgcn_permlane32_swap(ax, bx, false, false); const auto ry = __builtin_amdgcn_permlane32_swap(ay, by, false, false);
            *(u32x4*)(orow + 32 * d + 16 * gp) = (u32x4){rx[0], ry[0], rx[1], ry[1]}; }
#undef AT_ISSUE
#undef AT_WAITBAR
#undef AT_WAIT_NEWEST
#undef SB
#undef LDH
#undef MMH
#undef LDV
#undef MMV
#undef TRR
#undef LGKM
}

DI void gmlp_unit(LAS char* lds, bf16_t* zU, const bf16_t* zV, const float* g_ln, const float* b_ln, const bf16_t* Wb, const float* b_sp, int R0, bool dummy = false) {
    constexpr int WP = 272, VP = 320;
    int tid_ = threadIdx.x; asm volatile("" : "+v"(tid_));
    const int tid = tid_, lane = tid & 63, wid = __builtin_amdgcn_readfirstlane(tid >> 6), r = lane & 31, h = lane >> 5;
    LAS char* Wl = lds; LAS char* Vn = lds + 128 * WP; LAS float* St = (LAS float*)(lds + 128 * WP + 128 * VP);
    __syncthreads();
    { u32x4 rw[16];
#pragma unroll
      for (int i = 0; i < 16; ++i) rw[i] = *(const u32x4*)(zV + (size_t)(R0 + wid * 16 + i) * 512 + lane * 8);
#pragma unroll
      for (int i = 0; i < 16; ++i) { const int s = wid * 16 + i; const u32x4 w = rw[i];
        const float v[8] = {bflo(w.x), bfhi(w.x), bflo(w.y), bfhi(w.y), bflo(w.z), bfhi(w.z), bflo(w.w), bfhi(w.w)};
        float a = 0.f, q = 0.f;
#pragma unroll
        for (int e = 0; e < 8; ++e) { a += v[e]; q += v[e] * v[e]; }
        a = wave_sum(a); q = wave_sum(q);
        const float mu = a * (1.0f / 512.0f), var = fmaxf(q * (1.0f / 512.0f) - mu * mu, 0.f);
        if (lane == 0) { St[2 * s] = mu; St[2 * s + 1] = __builtin_amdgcn_rsqf(var + EPSN); } } }
    const int q4 = (lane & 15) >> 2, p4 = lane & 3, blk = (lane >> 4) & 1, cb = wid & 3, tp = wid >> 2;
    const int lt = tid >> 4, lc8 = (tid & 15) * 8;
    u32x4 pw[4], pv[4]; f32x4 pg[2], pb[2];
#define GM_FETCH(g) do { _Pragma("unroll") for (int i = 0; i < 4; ++i) { pw[i] = *(const u32x4*)(Wb + (size_t)(g) * 16384 + (lt + 32 * i) * 128 + lc8); pv[i] = *(const u32x4*)(zV + (size_t)(R0 + lt + 32 * i) * 512 + (g) * 128 + lc8); } \
        pg[0] = *(const f32x4*)(g_ln + (g) * 128 + lc8); pg[1] = *(const f32x4*)(g_ln + (g) * 128 + lc8 + 4); pb[0] = *(const f32x4*)(b_ln + (g) * 128 + lc8); pb[1] = *(const f32x4*)(b_ln + (g) * 128 + lc8 + 4); } while (0)
    GM_FETCH(0);
#pragma unroll 1
    for (int g = 0; g < 4; ++g) {
        __syncthreads();
#pragma unroll
        for (int i = 0; i < 4; ++i) { const int s = lt + 32 * i;
            *(LAS u32x4*)(Wl + s * WP + lc8 * 2) = pw[i];
            const u32x4 w = pv[i]; float v[8] = {bflo(w.x), bfhi(w.x), bflo(w.y), bfhi(w.y), bflo(w.z), bfhi(w.z), bflo(w.w), bfhi(w.w)};
            const float mu = St[2 * s], rsd = St[2 * s + 1];
#pragma unroll
            for (int e = 0; e < 8; ++e) v[e] = (v[e] - mu) * rsd * pg[e >> 2][e & 3] + pb[e >> 2][e & 3];
            u32x4 o; o.x = cvtpk(v[0], v[1]); o.y = cvtpk(v[2], v[3]); o.z = cvtpk(v[4], v[5]); o.w = cvtpk(v[6], v[7]); *(LAS u32x4*)(Vn + s * VP + lc8 * 2) = o; }
        __syncthreads();
        if (g + 1 < 4) GM_FETCH(g + 1);
        u32x2 uw[2][4]; float bs[2];
#pragma unroll
        for (int tb = 0; tb < 2; ++tb) { const int t = 32 * (2 * tp + tb) + r; bs[tb] = b_sp[g * 128 + t]; const bf16_t* up = zU + (size_t)(R0 + t) * 512 + g * 128 + 32 * cb + 4 * h;
#pragma unroll
            for (int k = 0; k < 4; ++k) uw[tb][k] = *(const u32x2*)(up + 8 * k); }
        f32x16 a0, a1;
#pragma unroll
        for (int i = 0; i < 16; ++i) { a0[i] = 0.f; a1[i] = 0.f; }
        const int tb0 = 2 * tp, tb1 = 2 * tp + 1;
        const LAS char* vb_ = Vn + (8 * h + q4) * VP + cb * 64 + blk * 32 + p4 * 8;
        bf16x8 af[8], b0f[8], b1f[8];
#pragma unroll
        for (int ss = 0; ss < 8; ++ss) {
            if (16 * ss <= 32 * tb1 + 31) {
                const s16x4 lo = vtr(vb_ + (16 * ss) * VP), hi = vtr(vb_ + (16 * ss + 4) * VP);
                af[ss] = (bf16x8){lo[0], lo[1], lo[2], lo[3], hi[0], hi[1], hi[2], hi[3]};
                b1f[ss] = *(const LAS bf16x8*)(Wl + (32 * tb1 + r) * WP + (16 * ss + 8 * h) * 2);
                if (16 * ss <= 32 * tb0 + 31) b0f[ss] = *(const LAS bf16x8*)(Wl + (32 * tb0 + r) * WP + (16 * ss + 8 * h) * 2); } }
        __builtin_amdgcn_sched_barrier(0);
#pragma unroll
        for (int ss = 0; ss < 8; ++ss) {
            if (16 * ss <= 32 * tb1 + 31) { a1 = MFMA32(af[ss], b1f[ss], a1); if (16 * ss <= 32 * tb0 + 31) a0 = MFMA32(af[ss], b0f[ss], a0); } }
#pragma unroll
        for (int tb = 0; tb < 2; ++tb) { const int t = 32 * (2 * tp + tb) + r; bf16_t* up = zU + (size_t)(R0 + t) * 512 + g * 128 + 32 * cb + 4 * h;
#pragma unroll
            for (int k = 0; k < 4; ++k) { const u32x2 u2 = uw[tb][k]; u32x2 w; const f32x16& a = tb ? a1 : a0; const float b_ = bs[tb];
                w.x = cvtpk(bflo(u2.x) * (a[4 * k] + b_), bfhi(u2.x) * (a[4 * k + 1] + b_)); w.y = cvtpk(bflo(u2.y) * (a[4 * k + 2] + b_), bfhi(u2.y) * (a[4 * k + 3] + b_));
                if (dummy) w = u2;
                *(u32x2*)(up + 8 * k) = w; } }
    }
#undef GM_FETCH
}

DI int srccol(int mat, int n) {
    if (mat == 0) { if (n < 1408) return n; if (n < 1472) { const int c = n - 1408; return 1664 + (c & 1) * 32 + (c >> 1); } if (n < 1536) return -1; if (n < 1792) return 1408 + (n - 1536); return n - 64; }
    if (mat == 1) { if (n < 1024) return (n >> 7) * 192 + (n & 127); const int c = n - 1024, hh = c >> 6, cc = c & 63; return hh * 192 + 128 + (cc & 1) * 32 + (cc >> 1); }
    if (mat == 2) { if (n < 1024) return (n >> 7) * 256 + (n & 127); const int c = n - 1024; return (c >> 7) * 256 + 128 + (c & 127); }
    return n;
}
DI void transpose_item(const float* W, const float* gain, int K, int Ns, int Nd, int mat, bf16_t* WT, LAS float* scr, int item, int lane) {
    const int nblk = Nd / 32, kb = item / nblk, nb = item % nblk, k0 = 64 * kb, n0 = 32 * nb;
    const int sc = srccol(mat, n0 + (lane & 31));
#pragma unroll 8
    for (int i = 0; i < 32; ++i) { const int kk = 2 * i + (lane >> 5); float v = 0.f; if (sc >= 0) v = W[(size_t)(k0 + kk) * Ns + sc]; if (gain) v *= gain[k0 + kk]; scr[kk * 33 + (lane & 31)] = v; }
    asm volatile("s_waitcnt lgkmcnt(0)" ::: "memory");
    const int c = lane & 7;
#pragma unroll
    for (int j = 0; j < 4; ++j) { const int n = (lane >> 3) + 8 * j; const LAS float* s = scr + (8 * c) * 33 + n;
        u32x4 o; o.x = cvtpk(s[0 * 33], s[1 * 33]); o.y = cvtpk(s[2 * 33], s[3 * 33]); o.z = cvtpk(s[4 * 33], s[5 * 33]); o.w = cvtpk(s[6 * 33], s[7 * 33]);
        *(u32x4*)(WT + (size_t)(n0 + n) * K + k0 + 8 * c) = o; }
    asm volatile("s_waitcnt lgkmcnt(0)" ::: "memory");
}
template <int NR> DI void rows_to_bf16(const float* x0, bf16_t* o0, float* rstd0, int rstride, int nvalid, int lane) {
    f32x4 v[NR][4];
#pragma unroll
    for (int r = 0; r < NR; ++r) { const f32x4* xr = (const f32x4*)(x0 + (size_t)(r < nvalid ? r : 0) * rstride * 1024) + lane;
#pragma unroll
        for (int j = 0; j < 4; ++j) v[r][j] = xr[64 * j]; }
#pragma unroll
    for (int r = 0; r < NR; ++r) { if (r >= nvalid) break; float s = 0.f;
#pragma unroll
        for (int j = 0; j < 4; ++j) s += (v[r][j][0] * v[r][j][0] + v[r][j][1] * v[r][j][1]) + (v[r][j][2] * v[r][j][2] + v[r][j][3] * v[r][j][3]);
        s = wave_sum(s);
        u32x2* o8 = (u32x2*)(o0 + (size_t)r * rstride * 1024) + lane;
#pragma unroll
        for (int j = 0; j < 4; ++j) { u32x2 w; w.x = cvtpk(v[r][j][0], v[r][j][1]); w.y = cvtpk(v[r][j][2], v[r][j][3]); o8[64 * j] = w; }
        if (lane == 0) rstd0[(size_t)r * rstride] = __builtin_amdgcn_rsqf(s * (1.0f / 1024.0f) + EPSN); }
}


#define RLX_AGENT __ATOMIC_RELAXED, __HIP_MEMORY_SCOPE_AGENT
#define XB_TMO      128
#define XB_XCNT(j)  (256  + 64 * (j))
#define XB_XSUB(j)  (1280 + 64 * (j))
#define XB_XGEN(j)  (2304 + 64 * (j))
#define XB_TOP      3328
#define XB_TOPGEN   3392
#define XCD_BAR_WORDS 3456
#define XB_SPIN_CAP (1u << 18)

__device__ __forceinline__ unsigned xb_ld(unsigned* p)              { return __hip_atomic_load(p, __ATOMIC_RELAXED, __HIP_MEMORY_SCOPE_AGENT); }
__device__ __forceinline__ unsigned xb_add(unsigned* p, unsigned v) { return __hip_atomic_fetch_add(p, v, __ATOMIC_RELAXED, __HIP_MEMORY_SCOPE_AGENT); }
__device__ __forceinline__ unsigned xb_xcc_id() { return (unsigned)__builtin_amdgcn_s_getreg((3 << 11) | 20) & 0xFu; }
#define XB_SPIN(cond, bar) do { unsigned _sp = 0; while (cond) { __builtin_amdgcn_s_sleep(1); \
    if ((++_sp & 255u) == 0u) { if (xb_ld(&(bar)[XB_TMO])) break; if (_sp > XB_SPIN_CAP) { atomicAdd(&(bar)[XB_TMO], 1u); break; } } } } while (0)

struct XcdBarrier {
    unsigned* bar; unsigned x;
    volatile LAS unsigned* st;
};

__device__ __forceinline__ XcdBarrier xcd_barrier_post(unsigned* bar, volatile LAS unsigned* st) {
    XcdBarrier b; b.bar = bar; b.x = xb_xcc_id(); b.st = st;
    if (threadIdx.x == 0) (void)xb_add(&bar[XB_XCNT(b.x)], 1u);
    return b;
}
__device__ __forceinline__ void xcd_barrier_complete(unsigned* bar, unsigned x, unsigned& nloc, unsigned& nx) {
    const unsigned G = gridDim.x * gridDim.y * gridDim.z;
    unsigned sum, cnt, mine, sp = 0u;
    for (;;) {
        sum = 0u; cnt = 0u; mine = 0u;
#pragma unroll
        for (unsigned j = 0; j < 16; ++j) { const unsigned c = xb_ld(&bar[XB_XCNT(j)]); sum += c; cnt += (c > 0u) ? 1u : 0u; mine = (j == x) ? c : mine; }
        if (sum == G) break;
        __builtin_amdgcn_s_sleep(1);
        if ((++sp & 255u) == 0u) { if (xb_ld(&bar[XB_TMO])) break; if (sp > XB_SPIN_CAP) { atomicAdd(&bar[XB_TMO], 1u); break; } }
    }
    nloc = mine > 0u ? mine : 1u; nx = cnt > 0u ? cnt : 1u;
}

__device__ __forceinline__ void xcd_barrier(const XcdBarrier& b) {
    asm volatile("s_waitcnt vmcnt(0)" ::: "memory");
    __syncthreads();
    if (threadIdx.x == 0) {
        unsigned* bar = b.bar;
        __builtin_amdgcn_s_waitcnt(0);
        unsigned nloc = b.st[0], nx = b.st[1];
        if (nloc == 0u) { xcd_barrier_complete(bar, b.x, nloc, nx); b.st[0] = nloc; b.st[1] = nx; }
        const unsigned old = xb_add(&bar[XB_XSUB(b.x)], 1u);
        const unsigned gen = old / nloc;
        if (old + 1u == (gen + 1u) * nloc) {
            __builtin_amdgcn_fence(__ATOMIC_RELEASE, "agent");
            asm volatile("s_waitcnt vmcnt(0)" ::: "memory");
            const unsigned og = xb_add(&bar[XB_TOP], 1u);
            const unsigned tg = og / nx;
            if (og + 1u == (tg + 1u) * nx) xb_add(&bar[XB_TOPGEN], 1u);
            else XB_SPIN(xb_ld(&bar[XB_TOPGEN]) == tg, bar);
            __builtin_amdgcn_fence(__ATOMIC_ACQUIRE, "agent");
            xb_add(&bar[XB_XGEN(b.x)], 1u);
            asm volatile("s_waitcnt vmcnt(0)" ::: "memory");
        } else {
            XB_SPIN(xb_ld(&bar[XB_XGEN(b.x)]) == gen, bar);
            __builtin_amdgcn_fence(__ATOMIC_ACQUIRE, "agent");
            asm volatile("s_waitcnt vmcnt(0)" ::: "memory");
        }
    }
    __syncthreads();
}

struct Args { const float* in[28]; float* out; unsigned char* ws; };

typedef const __attribute__((address_space(4))) Args* KArgP;
DI Bag make_bag(KArgP kp, LAS unsigned char* lds) {
    unsigned char* ws = kp->ws; Bag b;
    b.x = kp->in[0]; b.g_qn = kp->in[9]; b.g_qp = kp->in[10]; b.g_kn = kp->in[11]; b.g_kp = kp->in[12]; b.g_mq = kp->in[19]; b.g_mk = kp->in[20];
    b.rstd_x = (float*)(ws + S_RSX); b.rstd_mem = (float*)(ws + S_RSM); b.ssq_cq = (float*)(ws + S_SSQCQ); b.ssq_ckv = (float*)(ws + S_SSQCKV); b.ssq2 = (float*)(ws + S_SSQ2); b.rope = (const float*)(ws + S_ROPE);
    b.zU = (bf16_t*)(ws + A_ZU); b.zV = (bf16_t*)(ws + A_ZV); b.zCQ = (bf16_t*)(ws + A_ZCQ); b.zCKV = (bf16_t*)(ws + A_ZCKV); b.zQM = (bf16_t*)(ws + A_ZQM); b.zG = (bf16_t*)(ws + A_ZG);
    b.q = (bf16_t*)(ws + A_Q); b.kv = (bf16_t*)kp->out; b.memkv = (bf16_t*)(ws + A_MEMKV); b.merged = (bf16_t*)kp->out; b.x1b = (bf16_t*)(ws + A_X1B); b.hdn = (bf16_t*)(ws + A_HDN);
    b.x1 = (float*)(ws + A_X1); b.out = kp->out; b.P = (LAS float*)(lds + P_OFF);
    return b;
}
#define WSP(off) ((bf16_t*)(kp->ws + (off)))
#define FRESH() asm volatile("" : "+s"(kp))
#ifndef PHM
#define PHM 0xff
#endif
#ifndef P2M
#define P2M 15
#endif
__global__ void __launch_bounds__(512) mega_fwd(Args a_unused) {
    extern __shared__ __attribute__((aligned(16))) unsigned char lds_raw[];
    cg::grid_group grid = cg::this_grid();
    LAS unsigned char* lds = (LAS unsigned char*)lds_raw;
    const int tid = threadIdx.x, lane = tid & 63, wave = __builtin_amdgcn_readfirstlane(tid >> 6), G = gridDim.x, bid = blockIdx.x;
    KArgP kp = (KArgP)__builtin_amdgcn_kernarg_segment_ptr();
    (void)a_unused;
    volatile LAS unsigned* bst = (volatile LAS unsigned*)(lds + P_OFF + 8192);
    if (tid == 0) { bst[0] = 0u; bst[1] = 0u; }
    if (bid == 0) { unsigned* bw = (unsigned*)(kp->ws + S_BAR); for (int i = tid; i < XCD_BAR_WORDS; i += 512) __hip_atomic_store(bw + i, 0u, RLX_AGENT); }
    __syncthreads();

#ifndef REP_P0
#define REP_P0 1
#endif
#ifndef REP_P6
#define REP_P6 1
#endif
#pragma unroll 1
    for (int rep0 = 0; rep0 < REP_P0; ++rep0) {
        FRESH();
        unsigned char* ws = kp->ws;
        LAS float* scr = (LAS float*)(lds + wave * 16384);
        const int gw = bid * 8 + wave, NGW = G * 8;
        constexpr int I0 = 16 * 168, I1 = 6 * 48, I2 = 4 * 64, I3 = 16 * 32, I4 = 8 * 32, I5 = 16 * 32, I6 = 8 * 32, I7 = 16 * 32, I8 = 16 * 128, I9 = 64 * 32;
        constexpr int NIT = I0 + I1 + I2 + I3 + I4 + I5 + I6 + I7;
        for (int it = gw; it < NIT; it += NGW) {
            int r = it;
            if (r < I0) { transpose_item(kp->in[4], kp->in[3], 1024, 5312, 5376, 0, WSP(W_IN), scr, r, lane); continue; } r -= I0;
            if (r < I1) { transpose_item(kp->in[6], kp->in[5], 384, 1536, 1536, 1, WSP(W_UQ), scr, r, lane); continue; } r -= I1;
            if (r < I2) { transpose_item(kp->in[8], kp->in[7], 256, 2048, 2048, 2, WSP(W_UKV), scr, r, lane); continue; } r -= I2;
            if (r < I3) { transpose_item(kp->in[18], kp->in[17], 1024, 1024, 1024, 3, WSP(W_MKV), scr, r, lane); continue; } r -= I3;
            if (r < I4) { transpose_item(kp->in[21], nullptr, 512, 1024, 1024, 3, WSP(W_OGM), scr, r, lane); continue; } r -= I4;
            if (r < I5) { transpose_item(kp->in[22], nullptr, 1024, 1024, 1024, 3, WSP(W_OMLA), scr, r, lane); continue; } r -= I5;
            if (r < I6) { transpose_item(kp->in[23], nullptr, 512, 1024, 1024, 3, WSP(W_OMEM), scr, r, lane); continue; } r -= I6;
            transpose_item(kp->in[24], nullptr, 1024, 1024, 1024, 3, WSP(W_WOUT), scr, r, lane);
        }
        { const float* x = kp->in[0]; bf16_t* xb = WSP(A_XB); float* rsx = (float*)(ws + S_RSX);
          for (int m = gw; m < T; m += 4 * NGW) rows_to_bf16<4>(x + (size_t)m * 1024, xb + (size_t)m * 1024, rsx + m, NGW, (T - 1 - m) / NGW + 1, lane); }
        { const float* mem = kp->in[1]; bf16_t* memb = WSP(A_MEMB); float* rsm = (float*)(ws + S_RSM);
          for (int m = gw; m < MEMT; m += 4 * NGW) rows_to_bf16<4>(mem + (size_t)m * 1024, memb + (size_t)m * 1024, rsm + m, NGW, (MEMT - 1 - m) / NGW + 1, lane); }
        { const float* wsp = kp->in[15]; bf16_t* wb = WSP(S_WSP);
          for (int idx = bid * 512 + tid; idx < 4 * 128 * 128 / 2; idx += G * 512) { const int e = idx * 2, t = (e >> 7) & 127, sc = e & 127; const f32x2_t w = *(const f32x2_t*)(wsp + e);
              *(unsigned*)(wb + e) = cvtpk(sc <= t ? w[0] : 0.f, sc + 1 <= t ? w[1] : 0.f); } }
        { float* z1 = (float*)(ws + S_SSQCQ); float* z2 = (float*)(ws + S_SSQCKV); float* z3 = (float*)(ws + S_SSQ2);
          for (int i = bid * 512 + tid; i < T; i += G * 512) { z1[i] = 0.f; z2[i] = 0.f; z3[i] = 0.f; } }
        float* rope = (float*)(ws + S_ROPE); const int* pos = (const int*)kp->in[2];
        for (int idx = bid * 512 + tid; idx < T * 32; idx += G * 512) { const int row = idx >> 5, p = idx & 31;
            const float invf = exp2f(-(float)(2 * p) * (13.287712379549449f / 64.0f)); const float ang = (float)pos[row] * invf;
            const double rev = (double)ang * 0.15915494309189535; const float fr_ = (float)(rev - __builtin_rint(rev));
            rope[2 * (size_t)idx] = __builtin_amdgcn_cosf(fr_); rope[2 * (size_t)idx + 1] = __builtin_amdgcn_sinf(fr_); }
    }
    grid.sync();
    const XcdBarrier xbar = xcd_barrier_post((unsigned*)(kp->ws + S_BAR), bst);
    if (PHM & 2) {
#ifndef REP_P1
#define REP_P1 1
#endif
#pragma unroll 1
        for (int r1 = 0; r1 < REP_P1; ++r1) { FRESH(); Bag b = make_bag(kp, lds);
          if (REP_P1 > 1 && r1 + 1 < REP_P1) { b.ssq_cq = (float*)(kp->ws + 48 * MiB); b.ssq_ckv = (float*)(kp->ws + 49 * MiB); }
          pg8::Gemm g{WSP(A_XB), WSP(W_IN), T, 5376, 1024, 1024}; pg8::StaticOrder S; S.init(T, 5376, G, bid); Epi<K_Z> E{b, 0};
          pg8::gemm_phase<Epi<K_Z>, pg8::StaticOrder, true, true, 1024, 1024>(lds, g, S, E); }
        { const int c2 = (bid + 128) % G;
          if (G <= 128 || c2 >= 128) { FRESH(); __syncthreads();
            LAS float* scr = (LAS float*)(lds + wave * 16384);
            const int rank = (G > 128) ? c2 - 128 : bid, nidle = (G > 128) ? G - 128 : G;
            constexpr int I8 = 16 * 128, I9 = 64 * 32;
            for (int it = rank * 8 + wave; it < I8 + I9; it += nidle * 8) {
                if (it < I8) transpose_item(kp->in[26], kp->in[25], 1024, 4096, 4096, 3, WSP(W_FF1), scr, it, lane);
                else transpose_item(kp->in[27], nullptr, 4096, 1024, 1024, 3, WSP(W_FF2), scr, it - I8, lane); }
            __syncthreads(); } }
        { FRESH(); const Bag b = make_bag(kp, lds);
          pg8::Gemm g2{WSP(A_MEMB), WSP(W_MKV), MEMT, 1024, 1024, 1024}; pg8::StaticOrder S2; S2.init(MEMT, 1024, G, (bid + 128) % G); Epi<K_MEMKV> E2{b, 0};
          pg8::gemm_phase<Epi<K_MEMKV>, pg8::StaticOrder, true, true, 1024, 1024>(lds, g2, S2, E2); }
    }
    xcd_barrier(xbar);
    if (PHM & 4) {
#pragma unroll 1
      for (int k2 = 0; k2 < 2; ++k2) { const int part = (bid & 1) ? 1 - k2 : k2;
      if (part == 0) {
#ifndef REP_P2G
#define REP_P2G 1
#endif
#ifndef REP_GM
#define REP_GM 1
#endif
#pragma unroll 1
        for (int rg = 0; rg < REP_P2G; ++rg) {
        if (P2M & 1) { FRESH(); const Bag b = make_bag(kp, lds);
          pg8::Gemm g{b.zCQ, WSP(W_UQ), T, 1536, 384, 512}; pg8::StaticOrder S; S.init(T, 1536, G, bid); Epi<K_Q> E{b, 0};
          pg8::gemm_phase<Epi<K_Q>, pg8::StaticOrder, true, true, 384, 512>(lds, g, S, E); }
        if (P2M & 2) { FRESH(); const Bag b = make_bag(kp, lds);
          pg8::Gemm g2{b.zCKV, WSP(W_UKV), T, 2048, 256, 256}; pg8::StaticOrder S2; S2.init(T, 2048, G, bid); Epi<K_KV> E2{b, 0};
          pg8::gemm_phase<Epi<K_KV>, pg8::StaticOrder, true, true, 256, 256>(lds, g2, S2, E2); }
        }
      } else {
        __syncthreads();
        if (P2M & 4) { FRESH();
#pragma unroll 1
          for (int u = bid; u < 512 * REP_GM; u += G) gmlp_unit((LAS char*)lds, WSP(A_ZU), WSP(A_ZV), kp->in[13], kp->in[14], WSP(S_WSP), kp->in[16], (u & 511) * 128, REP_GM > 1 && u < 512 * (REP_GM - 1)); }
        if (P2M & 8) { FRESH(); bf16_t* zQM = WSP(A_ZQM); const bf16_t* memkv = WSP(A_MEMKV);
#pragma unroll 1
          for (int u0 = bid; u0 < 1024; u0 += G) { int u = u0;
            if (G == 256) { const int L = (u0 >> 8) * 32 + (bid >> 3); u = ((L >> 3) * 8 + (bid & 7)) * 8 + (L & 7); }
            const int bb = u >> 5, hh = (u >> 3) & 3, qb = u & 7;
            bf16_t* Q = zQM + (size_t)bb * SEQ * 512 + hh * 128; const bf16_t* Kp = memkv + (size_t)bb * MEML * 1024 + hh * 128;
            attn_unit<128, false>((LAS char*)lds, Q, 512, nullptr, 0, Kp, 1024, nullptr, 0, Kp + 512, 1024, Q, 512, qb * 256, 4); } }
      }
      __syncthreads();
      }
    }
    xcd_barrier(xbar);
    if (PHM & 8) {
        FRESH(); bf16_t* q = WSP(A_Q); const bf16_t* kv = (const bf16_t*)kp->out; const bf16_t* zCQ = WSP(A_ZCQ);
#ifndef REP_P3
#define REP_P3 1
#endif
#pragma unroll 1
        for (int it = bid; it < 1024 * REP_P3; it += G) { int bh = it & 255, pr = (it >> 8) & 3;
            if (G == 256) { bh = ((bid & 7) + 8 * (bid >> 5)) + 64 * ((it >> 8) & 3); pr = (bid >> 3) & 3; }
            const int bb = bh >> 3, hh = bh & 7;
            bf16_t* Qa = q + (size_t)bb * SEQ * 1536 + hh * 128; const bf16_t* Qb = q + (size_t)bb * SEQ * 1536 + 1024 + hh * 64;
            const bf16_t* Ka = kv + (size_t)bb * SEQ * 2048 + hh * 128; const bf16_t* Kb = zCQ + (size_t)bb * SEQ * 512 + 384; const bf16_t* Vp = Ka + 1024;
            bf16_t* Op = Qa; int pO = 1536;
            if (REP_P3 > 1 && it < 1024 * (REP_P3 - 1)) { Op = WSP(A_ZV) + (size_t)bb * SEQ * 512 + (hh & 3) * 128; pO = 512; }
#pragma unroll 1
            for (int k = 0; k < 2; ++k) { const int qb = k ? 7 - pr : pr;
#if defined(P3ABL)
                if (REP_P3 > 1 && it < 1024 * (REP_P3 - 1)) attn_unit<192, true, P3ABL>((LAS char*)lds, Qa, 1536, Qb, 1536, Ka, 2048, Kb, 512, Vp, 2048, Op, pO, qb * 256, 4 * (qb + 1)); else
#endif
                attn_unit<192, true>((LAS char*)lds, Qa, 1536, Qb, 1536, Ka, 2048, Kb, 512, Vp, 2048, Op, pO, qb * 256, 4 * (qb + 1)); } }
    }
    xcd_barrier(xbar);
    if (PHM & 16) {
        pg8::StaticOrder S; S.init(T, 1024, G, bid);
#ifndef REP_P4
#define REP_P4 1
#endif
#pragma unroll 1
        for (int r4 = 0; r4 < REP_P4; ++r4) {
#pragma unroll 1
        for (int k = 0; k < 3; ++k) {
            const int brn = (k == 2) ? 2 : ((bid & 1) ? 1 - k : k), fl = brn | ((k > 0) << 8);
            FRESH(); const Bag b = make_bag(kp, lds); Epi<K_OUT> E{b, fl};
            if (brn == 1) { pg8::Gemm g{b.q, WSP(W_OMLA), T, 1024, 1024, 1536}; pg8::gemm_phase<Epi<K_OUT>, pg8::StaticOrder, true, true, 1024, 1536>(lds, g, S, E); }
            else { pg8::Gemm g{brn == 0 ? b.zU : b.zQM, brn == 0 ? WSP(W_OGM) : WSP(W_OMEM), T, 1024, 512, 512}; pg8::gemm_phase<Epi<K_OUT>, pg8::StaticOrder, true, true, 512, 512>(lds, g, S, E); }
        }
        }
    }
    xcd_barrier(xbar);
#ifndef REP_P5
#define REP_P5 1
#endif
#pragma unroll 1
    for (int r5 = 0; r5 < REP_P5; ++r5) { FRESH(); Bag b = make_bag(kp, lds); if (REP_P5 > 1 && r5 + 1 < REP_P5) b.ssq2 = (float*)(kp->ws + 48 * MiB); pg8::Gemm g{b.merged, WSP(W_WOUT), T, 1024, 1024, 1024}; pg8::StaticOrder S; S.init(T, 1024, G, bid); Epi<K_WOUT> E{b, 0}; pg8::gemm_phase<Epi<K_WOUT>, pg8::StaticOrder, true, true, 1024, 1024>(lds, g, S, E); }
    xcd_barrier(xbar);
#pragma unroll 1
    for (int rep6 = 0; rep6 < REP_P6; ++rep6) { FRESH(); const Bag b = make_bag(kp, lds); pg8::Gemm g{b.x1b, WSP(W_FF1), T, 4096, 1024, 1024}; pg8::StaticOrder S; S.init(T, 4096, G, bid); Epi<K_FF1> E{b, 0}; pg8::gemm_phase<Epi<K_FF1>, pg8::StaticOrder, true, true, 1024, 1024>(lds, g, S, E); }
    xcd_barrier(xbar);
#ifndef REP_P7
#define REP_P7 1
#endif
#pragma unroll 1
    for (int r7 = 0; r7 < REP_P7; ++r7) { FRESH(); const Bag b = make_bag(kp, lds); pg8::Gemm g{b.hdn, WSP(W_FF2), T, 1024, 4096, 4096}; pg8::StaticOrder S; S.init(T, 1024, G, bid); Epi<K_FF2> E{b, 0}; pg8::gemm_phase<Epi<K_FF2>, pg8::StaticOrder, true, true, 4096, 4096>(lds, g, S, E); }
}

extern "C" void kernel_launch(void* const* d_in, const int* in_sizes, int n_in, void* d_out, int out_size, void* d_ws, size_t ws_size, hipStream_t stream) {
    static int grid_blocks = 0;
    if (grid_blocks == 0) {
        if (n_in != 28 || ws_size < WS_NEED) { fprintf(stderr, "kernel_launch: need 28 inputs and %zu bytes of workspace (got %d, %zu)\n", (size_t)WS_NEED, n_in, ws_size); grid_blocks = -1; return; }
        int dev = 0, cus = 0, per_cu = 0;
        hipGetDevice(&dev); hipDeviceGetAttribute(&cus, hipDeviceAttributeMultiprocessorCount, dev);
        if (hipFuncSetAttribute((const void*)mega_fwd, hipFuncAttributeMaxDynamicSharedMemorySize, LDS_BYTES) != hipSuccess) { fprintf(stderr, "kernel_launch: hipFuncSetAttribute failed\n"); grid_blocks = -1; return; }
        if (hipOccupancyMaxActiveBlocksPerMultiprocessor(&per_cu, (const void*)mega_fwd, 512, LDS_BYTES) != hipSuccess || per_cu < 1) { fprintf(stderr, "kernel_launch: occupancy query gave %d\n", per_cu); per_cu = 1; }
        (void)hipGetLastError();
        grid_blocks = cus * (per_cu > 1 ? 1 : per_cu);
    }
    if (grid_blocks < 0) return;
    Args a{};
    for (int i = 0; i < 28; ++i) a.in[i] = (const float*)d_in[i];
    a.out = (float*)d_out; a.ws = (unsigned char*)d_ws;
    void* args[] = {&a};
    hipError_t e = hipLaunchCooperativeKernel((const void*)mega_fwd, dim3(grid_blocks), dim3(512), args, LDS_BYTES, stream);
    if (e != hipSuccess) fprintf(stderr, "cooperative launch failed: %s (grid %d)\n", hipGetErrorString(e), grid_blocks);
}
```
